# Optimizing an MI355X kernel written in HIP

```python
import math
import jax, jax.numpy as jnp
from jax import lax
import numpy as np

D_MODEL = 2048
BATCH = 4
SEQ = 4096
DEPTH = 2

CTX_LEN = 256
GRID_W = 64
D_MIX = D_MODEL
MLA_HEADS = 8
MLA_NOPE = 128
MLA_ROPE = 64
MLA_V = 128
MLA_W = MLA_HEADS * MLA_V
Q_LORA = 512
KV_LORA = 256
ROPE_THETA = 10000.0
Q_BLOCK = 128
SCALE = (MLA_NOPE + MLA_ROPE) ** -0.5
HY_W = D_MIX - MLA_W
CONV_W = 3
FILT_EMB = 33
FILT_HIDDEN = 64
FILT_TARGET = 1e-2
FILT_FAST_DECAY = 0.3
FILT_SLOW_DECAY = 1.5
EPS = 1e-6
OFF_Q = 0
OFF_KV = OFF_Q + Q_LORA
OFF_KR = OFF_KV + KV_LORA
OFF_GM = OFF_KR + MLA_ROPE
OFF_HY = OFF_GM + MLA_W
OFF_GH = OFF_HY + 3 * HY_W
N_IN = OFF_GH + HY_W

kernel_name = "hymba_mla_hyena_prefix_dit"

F32 = jnp.float32


def rmsnorm(x, g):
    xf = x.astype(F32)
    y = xf * lax.rsqrt(jnp.mean(xf * xf, axis=-1, keepdims=True) + EPS)
    return (y * g.astype(F32)).astype(x.dtype)


def _modulation(cvec, ada_w, ada_b):
    m = jax.nn.silu(cvec) @ ada_w + ada_b
    return jnp.split(m, 3, axis=-1)


def _axial_rope_tables(n):
    rows = n // GRID_W
    row = jnp.repeat(jnp.arange(rows, dtype=F32), GRID_W)
    col = jnp.tile(jnp.arange(GRID_W, dtype=F32), rows)
    nf = MLA_ROPE // 4
    inv = ROPE_THETA ** (-jnp.arange(nf, dtype=F32) / nf)
    ang = jnp.stack([row[:, None] * inv, col[:, None] * inv], axis=1)
    return jnp.cos(ang), jnp.sin(ang)


def apply_axial_rope(x, cos, sin):
    xr = x.astype(F32).reshape(x.shape[:-1] + (2, 2, MLA_ROPE // 4))
    x1, x2 = xr[..., 0, :], xr[..., 1, :]
    out = jnp.stack([x1 * cos - x2 * sin, x2 * cos + x1 * sin], axis=-2)
    return out.reshape(x.shape).astype(x.dtype)


def _mla_q(p_q, lp):
    q = rmsnorm(p_q, lp["q_norm_g"]) @ lp["w_uq"]
    q = q.reshape(p_q.shape[:-1] + (MLA_HEADS, MLA_NOPE + MLA_ROPE))
    return q[..., :MLA_NOPE], q[..., MLA_NOPE:]


def _mla_kv(p_kv, lp):
    c_kv = rmsnorm(p_kv[..., :KV_LORA], lp["kv_norm_g"])
    kv = (c_kv @ lp["w_ukv"]).reshape(p_kv.shape[:-1] + (MLA_HEADS, MLA_NOPE + MLA_V))
    return kv[..., :MLA_NOPE], kv[..., MLA_NOPE:], p_kv[..., KV_LORA:]


def _attend(q_nope, q_rope, k_nope, k_rope, v):
    s = jnp.einsum("bqhd,bkhd->bhqk", q_nope, k_nope, preferred_element_type=F32)
    s = s + jnp.einsum("bqhr,bkr->bhqk", q_rope, k_rope, preferred_element_type=F32)
    p = jax.nn.softmax(s * SCALE, axis=-1)
    return jnp.einsum("bhqk,bkhd->bqhd", p.astype(v.dtype), v)


def _short_conv(u, w, b):
    L = u.shape[1]
    pad = CONV_W // 2
    up = jnp.pad(u, ((0, 0), (pad, pad), (0, 0)))
    out = b
    for j in range(CONV_W):
        out = out + up[:, j:j + L] * w[j]
    return out


def _implicit_filters(L, lp):
    t = jnp.linspace(0.0, 1.0, L, dtype=F32)[:, None]
    bands = (FILT_EMB - 1) // 2
    f = jnp.linspace(1e-4, bands - 1, bands, dtype=F32)[None, :]
    wpos = (2.0 * math.pi) * jnp.arange(L, dtype=F32)[:, None] / L
    z = jnp.concatenate([t, jnp.cos(f * wpos), -jnp.sin(f * wpos)], axis=-1)
    h = jnp.sin(lp["filt_freq"] * (z @ lp["filt_w1"] + lp["filt_b1"]))
    h = jnp.sin(lp["filt_freq"] * (h @ lp["filt_w2"] + lp["filt_b2"]))
    h = (h @ lp["filt_w3"]).astype(F32).reshape(L, 2, HY_W)
    deltas = jnp.linspace(math.log(FILT_TARGET) / FILT_FAST_DECAY,
                          math.log(FILT_TARGET) / FILT_SLOW_DECAY, HY_W, dtype=F32)
    decay = jnp.exp(-t * jnp.abs(deltas))
    h = h * decay[:, None, :]
    return h[:, 0], h[:, 1]


def _bidir_long_conv(u, h_f, h_b, d_bias):
    L = u.shape[1]
    k = jnp.concatenate([h_f, jnp.zeros((1, HY_W), F32), h_b[1:][::-1]], axis=0)
    kf = jnp.fft.rfft(k, n=2 * L, axis=0)
    uf32 = u.astype(F32)
    uf = jnp.fft.rfft(uf32, n=2 * L, axis=1)
    y = jnp.fft.irfft(uf * kf[None], n=2 * L, axis=1)[:, :L]
    return (y + uf32 * d_bias.astype(F32)).astype(u.dtype)


def _hyena(p_hy, lp):
    L = p_hy.shape[1]
    u = _short_conv(p_hy, lp["conv_w"], lp["conv_b"])
    x0, x1, v = jnp.split(u, 3, axis=-1)
    h_f, h_b = _implicit_filters(L, lp)
    return x0 * _bidir_long_conv(x1 * v, h_f, h_b, lp["hy_D"])


def _branch_merge(o_mla, p, lp):
    g_m = jax.nn.silu(p[..., OFF_GM:OFF_HY])
    g_h = jax.nn.silu(p[..., OFF_GH:N_IN])
    y_h = _hyena(p[..., OFF_HY:OFF_GH], lp)
    y = jnp.concatenate([rmsnorm(o_mla, lp["grp_g_mla"]) * g_m,
                         rmsnorm(y_h, lp["grp_g_hy"]) * g_h], axis=-1)
    return rmsnorm(y @ lp["w_out"], lp["post_g"])


def _layer(x, ctx, c, c_ctx, lp, cos, sin, update_ctx):
    B, L, _ = x.shape
    Lc = ctx.shape[1]
    sh_x, sc_x, g_x = [m[:, None, :] for m in _modulation(c, lp["ada_w"], lp["ada_b"])]
    sh_c, sc_c, g_c = _modulation(c_ctx, lp["ada_w"], lp["ada_b"])
    hx = rmsnorm(x, lp["pre_g"]) * (1.0 + sc_x) + sh_x
    hc = rmsnorm(ctx, lp["pre_g"]) * (1.0 + sc_c) + sh_c
    px = hx @ lp["w_in"]
    if update_ctx:
        pc = hc @ lp["w_in"]
        pc_kv = pc[..., OFF_KV:OFF_GM]
    else:
        pc_kv = hc @ lp["w_in"][:, OFF_KV:OFF_GM]
    kn_c, v_c, kr_c = _mla_kv(pc_kv, lp)
    kn_x, v_x, kr_x = _mla_kv(px[..., OFF_KV:OFF_GM], lp)
    kr_x = apply_axial_rope(kr_x, cos, sin)
    k_nope = jnp.concatenate([kn_c, kn_x], axis=1)
    k_rope = jnp.concatenate([kr_c, kr_x], axis=1)
    v = jnp.concatenate([v_c, v_x], axis=1)
    qn_x, qr_x = _mla_q(px[..., OFF_Q:OFF_KV], lp)
    qr_x = apply_axial_rope(qr_x, cos[:, None], sin[:, None])
    nb = L // Q_BLOCK

    def to_blocks(q):
        return q.reshape((B, nb, Q_BLOCK) + q.shape[2:]).swapaxes(0, 1)

    o_x = lax.map(lambda qs: _attend(qs[0], qs[1], k_nope, k_rope, v),
                  (to_blocks(qn_x), to_blocks(qr_x)))
    o_x = o_x.swapaxes(0, 1).reshape(B, L, MLA_W)
    x_new = x + g_x * _branch_merge(o_x, px, lp)
    if update_ctx:
        qn_c, qr_c = _mla_q(pc[..., OFF_Q:OFF_KV], lp)
        o_c = _attend(qn_c, qr_c, kn_c, kr_c, v_c).reshape(B, Lc, MLA_W)
        ctx = ctx + g_c * _branch_merge(o_c, pc, lp)
    return x_new, ctx


def setup_inputs(seed: int = 0) -> dict:
    key = jax.random.key(seed)
    ks = iter(jax.random.split(key, 32))

    def nrm(shape, s):
        return jax.random.normal(next(ks), shape, F32) * s

    def gain(shape):
        return 1.0 + nrm(shape, 0.05)

    return {
        "x": nrm((BATCH, SEQ, D_MODEL), 1.0),
        "c": nrm((BATCH, D_MODEL), 1.0),
        "ctx": nrm((BATCH, CTX_LEN, D_MODEL), 1.0),
        "c_ctx": nrm((D_MODEL,), 1.0),
        "ada_w": nrm((DEPTH, D_MODEL, 3 * D_MODEL), 0.5 * D_MODEL ** -0.5),
        "ada_b": nrm((DEPTH, 3 * D_MODEL), 0.01),
        "pre_g": gain((DEPTH, D_MODEL)),
        "w_in": nrm((DEPTH, D_MODEL, N_IN), D_MODEL ** -0.5),
        "q_norm_g": gain((DEPTH, Q_LORA)),
        "w_uq": nrm((DEPTH, Q_LORA, MLA_HEADS * (MLA_NOPE + MLA_ROPE)), Q_LORA ** -0.5),
        "kv_norm_g": gain((DEPTH, KV_LORA)),
        "w_ukv": nrm((DEPTH, KV_LORA, MLA_HEADS * (MLA_NOPE + MLA_V)), KV_LORA ** -0.5),
        "conv_w": nrm((DEPTH, CONV_W, 3 * HY_W), CONV_W ** -0.5),
        "conv_b": nrm((DEPTH, 3 * HY_W), 0.02),
        "filt_w1": nrm((DEPTH, FILT_EMB, FILT_HIDDEN), FILT_EMB ** -0.5),
        "filt_b1": nrm((DEPTH, FILT_HIDDEN), 0.1),
        "filt_freq": gain((DEPTH, FILT_HIDDEN)),
        "filt_w2": nrm((DEPTH, FILT_HIDDEN, FILT_HIDDEN), FILT_HIDDEN ** -0.5),
        "filt_b2": nrm((DEPTH, FILT_HIDDEN), 0.1),
        "filt_w3": nrm((DEPTH, FILT_HIDDEN, 2 * HY_W), FILT_HIDDEN ** -0.5),
        "hy_D": nrm((DEPTH, HY_W), 1.0),
        "grp_g_mla": gain((DEPTH, MLA_W)),
        "grp_g_hy": gain((DEPTH, HY_W)),
        "w_out": nrm((DEPTH, D_MIX, D_MODEL), D_MIX ** -0.5),
        "post_g": gain((DEPTH, D_MODEL)),
    }


def reference(x, c, ctx, c_ctx, ada_w, ada_b, pre_g, w_in, q_norm_g, w_uq, kv_norm_g, w_ukv,
              conv_w, conv_b, filt_w1, filt_b1, filt_freq, filt_w2, filt_b2, filt_w3, hy_D,
              grp_g_mla, grp_g_hy, w_out, post_g):
    cos, sin = _axial_rope_tables(x.shape[1])
    for l in range(DEPTH):
        lp = {
            "ada_w": ada_w[l], "ada_b": ada_b[l], "pre_g": pre_g[l], "w_in": w_in[l],
            "q_norm_g": q_norm_g[l], "w_uq": w_uq[l], "kv_norm_g": kv_norm_g[l], "w_ukv": w_ukv[l],
            "conv_w": conv_w[l], "conv_b": conv_b[l], "filt_w1": filt_w1[l], "filt_b1": filt_b1[l],
            "filt_freq": filt_freq[l], "filt_w2": filt_w2[l], "filt_b2": filt_b2[l],
            "filt_w3": filt_w3[l], "hy_D": hy_D[l], "grp_g_mla": grp_g_mla[l],
            "grp_g_hy": grp_g_hy[l], "w_out": w_out[l], "post_g": post_g[l],
        }
        x, ctx = _layer(x, ctx, c, c_ctx, lp, cos, sin, update_ctx=(l < DEPTH - 1))
    return x
```

```cpp
#include <hip/hip_runtime.h>
#include <hip/hip_cooperative_groups.h>
#include <cstdio>
namespace cg = cooperative_groups;

typedef unsigned short bf16;
using bf16x8 = __attribute__((ext_vector_type(8))) short;
using f32x4 = __attribute__((ext_vector_type(4))) float;

constexpr int DM = 2048, SEQ = 4096, CTXL = 256;
constexpr int TX = 16384, TC = 1024, TT = 17408;
constexpr int NIN = 5952, NPA = 2944, NHYC = 3072, NPADW = 6016;
constexpr int LK = 4352;
constexpr int QW = 1536;
constexpr float EPSN = 1e-6f;
constexpr float QSCALE = 0.07216878364870322f * 1.4426950408889634f;
constexpr int LDS_BYTES = 69632;
constexpr int NT = 256;

struct Params {
  const float *x, *c, *ctx, *c_ctx, *ada_w, *ada_b, *pre_g, *w_in, *q_norm_g, *w_uq, *kv_norm_g, *w_ukv, *conv_w, *conv_b,
      *filt_w1, *filt_b1, *filt_freq, *filt_w2, *filt_b2, *filt_w3, *hy_D, *grp_g_mla, *grp_g_hy, *w_out, *post_g;
  float* out;
  bf16 *wT_in, *wT_uq, *wT_ukv, *wT_out;
  float *mod, *h2T, *h2cT, *rope;
  bf16 *xh, *pa, *pT, *pchy;
  float* z;
  bf16 *qbuf, *Kn, *kr, *vT, *yhT;
  float* ctx1;
  float* kfg;
};

__device__ __forceinline__ bf16 f2bf(float f) {
  unsigned u = __float_as_uint(f);
  u += 0x7fffu + ((u >> 16) & 1u);
  return (bf16)(u >> 16);
}
__device__ __forceinline__ float bf2f(bf16 h) { return __uint_as_float(((unsigned)h) << 16); }
__device__ __forceinline__ unsigned pack2(float a, float b) { return (unsigned)f2bf(a) | ((unsigned)f2bf(b) << 16); }
__device__ __forceinline__ float wave_sum(float v) {
#pragma unroll
  for (int o = 32; o > 0; o >>= 1) v += __shfl_xor(v, o);
  return v;
}
__device__ __forceinline__ int launder(int v) { asm volatile("" : "+v"(v)); return v; }
__device__ __forceinline__ float launderf(float v) { asm volatile("" : "+v"(v)); return v; }
__device__ __forceinline__ float siluf(float v) { return v / (1.f + __expf(-v)); }

#define HD __device__ __forceinline__
struct cf { float x, y; };
HD cf cmul(cf a, cf b) { return cf{a.x * b.x - a.y * b.y, a.x * b.y + a.y * b.x}; }
HD cf cmulc(cf a, cf b) { return cf{a.x * b.x + a.y * b.y, a.y * b.x - a.x * b.y}; }
HD cf cadd(cf a, cf b) { return cf{a.x + b.x, a.y + b.y}; }
HD cf csub(cf a, cf b) { return cf{a.x - b.x, a.y - b.y}; }
template <bool INV> HD void dft4(cf& a0, cf& a1, cf& a2, cf& a3) {
  cf s02 = cadd(a0, a2), d02 = csub(a0, a2), s13 = cadd(a1, a3), d13 = csub(a1, a3);
  cf r = INV ? cf{-d13.y, d13.x} : cf{d13.y, -d13.x};
  a0 = cadd(s02, s13); a2 = csub(s02, s13); a1 = cadd(d02, r); a3 = csub(d02, r);
}
#define W16C1 0.92387953251128674f
#define W16S1 0.38268343236508977f
#define W16R2 0.70710678118654752f
template <bool INV> HD cf w16(int m) {
  float c, s;
  switch (m) {
    case 0: c = 1.f; s = 0.f; break;
    case 1: c = W16C1; s = W16S1; break;
    case 2: c = W16R2; s = W16R2; break;
    case 3: c = W16S1; s = W16C1; break;
    case 4: c = 0.f; s = 1.f; break;
    case 6: c = -W16R2; s = W16R2; break;
    default: c = -W16C1; s = -W16S1; break;
  }
  return cf{c, INV ? s : -s};
}
template <bool INV> HD void dft16_nt(cf* x) {
#pragma unroll
  for (int b = 0; b < 4; ++b) dft4<INV>(x[b], x[4 + b], x[8 + b], x[12 + b]);
#pragma unroll
  for (int c = 1; c < 4; ++c)
#pragma unroll
    for (int b = 1; b < 4; ++b) x[4 * c + b] = cmul(x[4 * c + b], w16<INV>(b * c));
#pragma unroll
  for (int c = 0; c < 4; ++c) dft4<INV>(x[4 * c], x[4 * c + 1], x[4 * c + 2], x[4 * c + 3]);
}
template <bool INV> HD void dft16_tn(cf* x) {
#pragma unroll
  for (int c = 0; c < 4; ++c) dft4<INV>(x[4 * c], x[4 * c + 1], x[4 * c + 2], x[4 * c + 3]);
#pragma unroll
  for (int c = 1; c < 4; ++c)
#pragma unroll
    for (int b = 1; b < 4; ++b) x[4 * c + b] = cmul(x[4 * c + b], w16<INV>(b * c));
#pragma unroll
  for (int b = 0; b < 4; ++b) dft4<INV>(x[b], x[4 + b], x[8 + b], x[12 + b]);
}
#define KOF(r) (((r) >> 2) + 4 * ((r) & 3))
#define PADI(p) ((p) + ((p) >> 4))
struct FftTw { cf c1, c2, c4, c5; };
HD void fwd_p1(cf* x, int t, const FftTw& tw, cf* lds) {
  dft16_nt<false>(x);
  __builtin_amdgcn_sched_barrier(0);
  cf pw = cf{1.f, 0.f};
#pragma unroll
  for (int k = 0; k < 16; ++k) { lds[(t + (t >> 4)) + 272 * k] = cmul(x[KOF(k)], pw); pw = cmul(pw, tw.c1); if ((k & 3) == 3) __builtin_amdgcn_sched_barrier(0); }
}
HD void fwd_p2(cf* x, int t, const FftTw& tw, cf* lds) {
  int k1 = t >> 4, n2b = t & 15;
#pragma unroll
  for (int j = 0; j < 16; ++j) x[j] = lds[(272 * k1 + n2b) + 17 * j];
  __builtin_amdgcn_sched_barrier(0);
  dft16_nt<false>(x);
  __builtin_amdgcn_sched_barrier(0);
  cf pw = cf{1.f, 0.f};
#pragma unroll
  for (int k = 0; k < 16; ++k) { lds[(272 * k1 + n2b) + 17 * k] = cmul(x[KOF(k)], pw); pw = cmul(pw, tw.c2); __builtin_amdgcn_sched_barrier(0); }
}
HD void fwd_p3(cf* x, int t, cf* lds) {
#pragma unroll
  for (int j = 0; j < 16; ++j) x[j] = lds[17 * t + j];
  dft16_nt<false>(x);
}
HD void inv_p3(cf* x, int t, const FftTw& tw, cf* lds) {
  dft16_tn<true>(x);
  __builtin_amdgcn_sched_barrier(0);
  cf pw = cf{1.f, 0.f};
#pragma unroll
  for (int n = 0; n < 16; ++n) { lds[17 * t + n] = cmulc(x[n], pw); pw = cmul(pw, tw.c2); __builtin_amdgcn_sched_barrier(0); }
}
HD void inv_p2(cf* x, int t, const FftTw& tw, cf* lds) {
  int k1 = t >> 4, n2b = t & 15;
#pragma unroll
  for (int j = 0; j < 16; ++j) x[j] = lds[(272 * k1 + n2b) + 17 * j];
  dft16_nt<true>(x);
  __builtin_amdgcn_sched_barrier(0);
  cf pw = tw.c4;
#pragma unroll
  for (int k = 0; k < 16; ++k) { lds[(272 * k1 + n2b) + 17 * k] = cmulc(x[KOF(k)], pw); pw = cmul(pw, tw.c5); if ((k & 3) == 3) __builtin_amdgcn_sched_barrier(0); }
}
HD void inv_p1(cf* x, int t, cf* lds) {
#pragma unroll
  for (int r = 0; r < 16; ++r) x[r] = lds[(t + (t >> 4)) + 272 * KOF(r)];
  dft16_tn<true>(x);
}
HD void fft_fwd(cf* x, int t, const FftTw& tw0, cf* lds) {
  FftTw tw; tw.c1 = cf{launderf(tw0.c1.x), launderf(tw0.c1.y)}; tw.c2 = cf{launderf(tw0.c2.x), launderf(tw0.c2.y)}; tw.c4 = tw0.c4; tw.c5 = tw0.c5;
  fwd_p1(x, t, tw, lds); __syncthreads();
  fwd_p2(x, t, tw, lds); __syncthreads();
  fwd_p3(x, t, lds); __syncthreads();
}
HD void fft_inv(cf* x, int t, const FftTw& tw0, cf* lds) {
  FftTw tw; tw.c2 = cf{launderf(tw0.c2.x), launderf(tw0.c2.y)}; tw.c4 = cf{launderf(tw0.c4.x), launderf(tw0.c4.y)}; tw.c5 = cf{launderf(tw0.c5.x), launderf(tw0.c5.y)}; tw.c1 = tw0.c1;
  inv_p3(x, t, tw, lds); __syncthreads();
  inv_p2(x, t, tw, lds); __syncthreads();
  inv_p1(x, t, lds); __syncthreads();
}
HD cf cispi(float a) { float s, c; sincospif(a, &s, &c); return cf{c, s}; }

__device__ __forceinline__ void gemm_tile(const bf16* __restrict__ A, int lda, const bf16* __restrict__ Bt, int ldb, int K, char* smem,
                                          f32x4 (&acc)[4][4]) {
  const int tid = launder(threadIdx.x), lane = tid & 63, w = tid >> 6, wr = w >> 1, wc = w & 1, l15 = lane & 15, quad = lane >> 4;
#pragma unroll
  for (int m = 0; m < 4; ++m)
#pragma unroll
    for (int n = 0; n < 4; ++n) acc[m][n] = f32x4{0.f, 0.f, 0.f, 0.f};
  uint4 ra[4], rb[4];
  const int nk = K >> 6;
  const bf16* ga[4]; const bf16* gb[4]; int so[4];
#pragma unroll
  for (int q = 0; q < 4; ++q) {
    int id = tid + 256 * q, r = id >> 3, ch = id & 7;
    ga[q] = A + (size_t)r * lda + ch * 8;
    gb[q] = Bt + (size_t)r * ldb + ch * 8;
    so[q] = r * 128 + ((ch ^ (r & 7)) << 4);
  }
#pragma unroll
  for (int q = 0; q < 4; ++q) { ra[q] = *(const uint4*)(ga[q]); rb[q] = *(const uint4*)(gb[q]); }
#pragma unroll
  for (int q = 0; q < 4; ++q) { *(uint4*)(smem + so[q]) = ra[q]; *(uint4*)(smem + 16384 + so[q]) = rb[q]; }
  __syncthreads();
  for (int kt = 0; kt < nk; ++kt) {
    char* cur = smem + (kt & 1) * 32768;
    char* nxt = smem + ((kt + 1) & 1) * 32768;
    if (kt + 1 < nk) {
#pragma unroll
      for (int q = 0; q < 4; ++q) { ra[q] = *(const uint4*)(ga[q] + (kt + 1) * 64); rb[q] = *(const uint4*)(gb[q] + (kt + 1) * 64); }
    }
#pragma unroll
    for (int kk = 0; kk < 2; ++kk) {
      bf16x8 af[4], bfr[4];
#pragma unroll
      for (int m = 0; m < 4; ++m) {
        int r = wr * 64 + m * 16 + l15;
        af[m] = *(const bf16x8*)(cur + r * 128 + (((kk * 4 + quad) ^ (r & 7)) << 4));
      }
#pragma unroll
      for (int n = 0; n < 4; ++n) {
        int r = wc * 64 + n * 16 + l15;
        bfr[n] = *(const bf16x8*)(cur + 16384 + r * 128 + (((kk * 4 + quad) ^ (r & 7)) << 4));
      }
#pragma unroll
      for (int m = 0; m < 4; ++m)
#pragma unroll
        for (int n = 0; n < 4; ++n) acc[m][n] = __builtin_amdgcn_mfma_f32_16x16x32_bf16(af[m], bfr[n], acc[m][n], 0, 0, 0);
    }
    if (kt + 1 < nk) {
#pragma unroll
      for (int q = 0; q < 4; ++q) { *(uint4*)(nxt + so[q]) = ra[q]; *(uint4*)(nxt + 16384 + so[q]) = rb[q]; }
    }
    __syncthreads();
  }
}

__device__ void transpose_tile(const float* __restrict__ src, int ldsrc, int k0, int srccol0, bf16* __restrict__ dst, int lddst, int dstrow0,
                               const float* __restrict__ gk, bool zero, char* smem) {
  float* tl = (float*)smem;
  const int tid = threadIdx.x;
#pragma unroll 4
  for (int i = 0; i < 16; ++i) {
    int kk = (tid >> 6) + 4 * i, nn = tid & 63;
    float v = zero ? 0.f : src[(size_t)(k0 + kk) * ldsrc + srccol0 + nn];
    if (gk) v *= gk[k0 + kk];
    tl[kk * 65 + nn] = v;
  }
  __syncthreads();
#pragma unroll
  for (int i = 0; i < 2; ++i) {
    int id = tid + 256 * i, nn = id >> 3, kc = id & 7;
    uint4 o;
    o.x = pack2(tl[(kc * 8 + 0) * 65 + nn], tl[(kc * 8 + 1) * 65 + nn]);
    o.y = pack2(tl[(kc * 8 + 2) * 65 + nn], tl[(kc * 8 + 3) * 65 + nn]);
    o.z = pack2(tl[(kc * 8 + 4) * 65 + nn], tl[(kc * 8 + 5) * 65 + nn]);
    o.w = pack2(tl[(kc * 8 + 6) * 65 + nn], tl[(kc * 8 + 7) * 65 + nn]);
    *(uint4*)(dst + (size_t)(dstrow0 + nn) * lddst + k0 + kc * 8) = o;
  }
  __syncthreads();
}
__device__ void win_transpose_task(const Params& P, int l, int task, char* smem) {
  int nt = task >> 5, kt = task & 31;
  int n0 = nt * 64;
  int srccol; bool zero = false;
  if (n0 < 1856) srccol = n0;
  else if (n0 < 2880) srccol = 4928 + (n0 - 1856);
  else if (n0 < 2944) { srccol = 0; zero = true; }
  else srccol = 1856 + (n0 - 2944);
  transpose_tile(P.w_in + (size_t)l * DM * NIN, NIN, kt * 64, srccol, P.wT_in, DM, n0, nullptr, zero, smem);
}
__device__ void modulation_task(const Params& P, int task, char* smem) {
  float* s = (float*)smem;
  float* red = s + 5 * 2048;
  const int tid = threadIdx.x;
  int l = task / 96, cgp = task % 96;
  for (int i = tid; i < 5 * 2048; i += NT) {
    int v = i >> 11, k = i & 2047;
    float cv = (v < 4) ? P.c[v * 2048 + k] : P.c_ctx[k];
    s[i] = cv / (1.f + expf(-cv));
  }
  __syncthreads();
  int kg = tid >> 6, cj = tid & 63, col = cgp * 64 + cj;
  float acc[5] = {0.f, 0.f, 0.f, 0.f, 0.f};
  const float* wp = P.ada_w + ((size_t)l * 2048 + kg * 512) * 6144 + col;
  const float* sp = s + kg * 512;
#pragma unroll 8
  for (int k = 0; k < 512; ++k) {
    float wv = wp[(size_t)k * 6144];
#pragma unroll
    for (int v = 0; v < 5; ++v) acc[v] += sp[v * 2048 + k] * wv;
  }
#pragma unroll
  for (int v = 0; v < 5; ++v) red[(kg * 5 + v) * 64 + cj] = acc[v];
  __syncthreads();
  for (int i = tid; i < 320; i += NT) {
    int v = i >> 6, c2 = i & 63;
    float a = red[(0 * 5 + v) * 64 + c2] + red[(1 * 5 + v) * 64 + c2] + red[(2 * 5 + v) * 64 + c2] + red[(3 * 5 + v) * 64 + c2];
    int cc = cgp * 64 + c2;
    P.mod[(size_t)(l * 5 + v) * 6144 + cc] = a + P.ada_b[l * 6144 + cc];
  }
  __syncthreads();
}
__device__ void h2_task(const Params& P, int task, char* smem) {
  float* zf = (float*)smem;
  float* h1 = zf + 4 * 36;
  const int tid = threadIdx.x, pos = tid >> 6, j = tid & 63;
  int which, n0;
  if (task < 1024) { which = 0; n0 = task * 4; }
  else if (task < 2048) { which = 1; n0 = (task - 1024) * 4; }
  else { which = 2; n0 = (task - 2048) * 4; }
  const int Lc = (which == 2) ? 256 : 4096;
  const int l = (which == 1) ? 1 : 0;
  const int n = n0 + pos;
  if (j < 33) {
    float v;
    if (j == 0) v = (float)n / (float)(Lc - 1);
    else {
      int k = (j - 1) & 15;
      float f = 1e-4f + (float)k * ((15.f - 1e-4f) / 15.f);
      float wpos = (6.283185307179586f * (float)n) / (float)Lc;
      float a = f * wpos;
      v = (j <= 16) ? cosf(a) : -sinf(a);
    }
    zf[pos * 36 + j] = v;
  }
  __syncthreads();
  float fr = P.filt_freq[l * 64 + j];
  float a = P.filt_b1[l * 64 + j];
#pragma unroll
  for (int i = 0; i < 33; ++i) a += zf[pos * 36 + i] * P.filt_w1[(l * 33 + i) * 64 + j];
  h1[pos * 64 + j] = sinf(fr * a);
  __syncthreads();
  float a2 = P.filt_b2[l * 64 + j];
#pragma unroll 8
  for (int i = 0; i < 64; ++i) a2 += h1[pos * 64 + i] * P.filt_w2[(l * 64 + i) * 64 + j];
  float hv = sinf(fr * a2);
  if (which == 2) P.h2cT[j * 256 + n] = hv;
  else P.h2T[((size_t)l * 64 + j) * 4096 + n] = hv;
  __syncthreads();
}
__device__ void rope_table_task(const Params& P) {
  for (int i = threadIdx.x; i < 64 * 16; i += NT) {
    int pos = i >> 4, f = i & 15;
    float inv = powf(10000.f, -(float)f / 16.f);
    float ang = (float)pos * inv;
    P.rope[2 * i] = cosf(ang);
    P.rope[2 * i + 1] = sinf(ang);
  }
}

__device__ __forceinline__ void prenorm_store(const Params& P, const float4* v, int row, int l, int mv, int lane) {
  float ss = 0.f;
#pragma unroll
  for (int i = 0; i < 8; ++i) ss += v[i].x * v[i].x + v[i].y * v[i].y + v[i].z * v[i].z + v[i].w * v[i].w;
  ss = wave_sum(ss);
  float r = rsqrtf(ss * (1.f / 2048.f) + EPSN);
  const float* md = P.mod + (size_t)(l * 5 + mv) * 6144;
#pragma unroll
  for (int i = 0; i < 8; ++i) {
    int idx = (i * 64 + lane) * 4;
    float4 g = *(const float4*)(P.pre_g + l * 2048 + idx);
    float4 sh = *(const float4*)(md + idx);
    float4 sc = *(const float4*)(md + 2048 + idx);
    float o0 = v[i].x * r * g.x * (1.f + sc.x) + sh.x;
    float o1 = v[i].y * r * g.y * (1.f + sc.y) + sh.y;
    float o2 = v[i].z * r * g.z * (1.f + sc.z) + sh.z;
    float o3 = v[i].w * r * g.w * (1.f + sc.w) + sh.w;
    uint2 o; o.x = pack2(o0, o1); o.y = pack2(o2, o3);
    *(uint2*)(P.xh + (size_t)row * 2048 + idx) = o;
  }
}
__device__ void phase_prenorm0(const Params& P) {
  const int lane = threadIdx.x & 63, wv = threadIdx.x >> 6;
  for (int row = blockIdx.x * 4 + wv; row < TT; row += gridDim.x * 4) {
    const float* src = (row < TX) ? (P.x + (size_t)row * 2048) : (P.ctx + (size_t)(row - TX) * 2048);
    int mv = (row < TX) ? (row >> 12) : 4;
    float4 v[8];
#pragma unroll
    for (int i = 0; i < 8; ++i) v[i] = *(const float4*)(src + (i * 64 + lane) * 4);
    prenorm_store(P, v, row, 0, mv, lane);
  }
}
__device__ void phase_post(const Params& P, int l) {
  const int lane = threadIdx.x & 63, wv = threadIdx.x >> 6;
  const int nrows = (l == 0) ? TT : TX;
  for (int row = blockIdx.x * 4 + wv; row < nrows; row += gridDim.x * 4) {
    const bool isx = row < TX;
    int mv = isx ? (row >> 12) : 4;
    const float* zr = P.z + (size_t)row * 2048;
    const float* xo = (l == 0) ? (isx ? P.x + (size_t)row * 2048 : P.ctx + (size_t)(row - TX) * 2048) : (P.out + (size_t)row * 2048);
    float* xn = isx ? (P.out + (size_t)row * 2048) : (P.ctx1 + (size_t)(row - TX) * 2048);
    float4 zv[8];
    float ss = 0.f;
#pragma unroll
    for (int i = 0; i < 8; ++i) {
      zv[i] = *(const float4*)(zr + (i * 64 + lane) * 4);
      ss += zv[i].x * zv[i].x + zv[i].y * zv[i].y + zv[i].z * zv[i].z + zv[i].w * zv[i].w;
    }
    ss = wave_sum(ss);
    float r = rsqrtf(ss * (1.f / 2048.f) + EPSN);
    const float* gt = P.mod + (size_t)(l * 5 + mv) * 6144 + 4096;
#pragma unroll
    for (int i = 0; i < 8; ++i) {
      int idx = (i * 64 + lane) * 4;
      float4 xv = *(const float4*)(xo + idx);
      float4 g = *(const float4*)(gt + idx);
      float4 pg = *(const float4*)(P.post_g + l * 2048 + idx);
      zv[i].x = xv.x + g.x * zv[i].x * r * pg.x;
      zv[i].y = xv.y + g.y * zv[i].y * r * pg.y;
      zv[i].z = xv.z + g.z * zv[i].z * r * pg.z;
      zv[i].w = xv.w + g.w * zv[i].w * r * pg.w;
      *(float4*)(xn + idx) = zv[i];
    }
    if (l == 0) prenorm_store(P, zv, row, 1, mv, lane);
  }
  if (l == 0) {
  }
}

__device__ void gemm_in_task(const Params& P, int l, int mt, int nt, char* smem) {
  f32x4 acc[4][4];
  const int row0 = mt * 128, col0 = nt * 128;
  gemm_tile(P.xh + (size_t)row0 * DM, DM, P.wT_in + (size_t)col0 * DM, DM, DM, smem, acc);
  const int tid = threadIdx.x, lane = tid & 63, w = tid >> 6, wr = w >> 1, wc = w & 1, l15 = lane & 15, quad = lane >> 4;
  const int rowbase = row0 + wr * 64, colbase = col0 + wc * 64;
  const bool isx = row0 < TX;
  if (colbase < NPA) {
    if (colbase == 768) {
#pragma unroll
      for (int m = 0; m < 4; ++m)
#pragma unroll
        for (int j = 0; j < 4; ++j) {
          int row = rowbase + m * 16 + quad * 4 + j;
          float v0 = acc[m][0][j], v1 = acc[m][1][j], v2 = acc[m][2][j], v3 = acc[m][3][j];
          int b, kk;
          if (isx) {
            int t = row & 4095; b = row >> 12; kk = 256 + t;
            float2 cs0 = *(const float2*)(P.rope + 2 * ((t >> 6) * 16 + l15));
            float2 cs1 = *(const float2*)(P.rope + 2 * ((t & 63) * 16 + l15));
            float a0 = v0 * cs0.x - v1 * cs0.y, a1 = v1 * cs0.x + v0 * cs0.y;
            float a2 = v2 * cs1.x - v3 * cs1.y, a3 = v3 * cs1.x + v2 * cs1.y;
            v0 = a0; v1 = a1; v2 = a2; v3 = a3;
          } else { int rc = row - TX; b = rc >> 8; kk = rc & 255; }
          bf16* dst = P.kr + ((size_t)b * LK + kk) * 64 + l15;
          dst[0] = f2bf(v0); dst[16] = f2bf(v1); dst[32] = f2bf(v2); dst[48] = f2bf(v3);
        }
    } else {
#pragma unroll
      for (int m = 0; m < 4; ++m)
#pragma unroll
        for (int n = 0; n < 4; ++n)
#pragma unroll
          for (int j = 0; j < 4; ++j) {
            int row = rowbase + m * 16 + quad * 4 + j, col = colbase + n * 16 + l15;
            P.pa[(size_t)row * NPA + col] = f2bf(acc[m][n][j]);
          }
    }
  } else {
    const int hc0 = colbase - NPA;
    if (isx) {
      const int b = row0 >> 12, t0 = (rowbase & 4095);
#pragma unroll
      for (int m = 0; m < 4; ++m)
#pragma unroll
        for (int n = 0; n < 4; ++n) {
          int hc = hc0 + n * 16 + l15, t = t0 + m * 16 + quad * 4;
          uint2 o; o.x = pack2(acc[m][n][0], acc[m][n][1]); o.y = pack2(acc[m][n][2], acc[m][n][3]);
          *(uint2*)(P.pT + ((size_t)b * NHYC + hc) * 4096 + t) = o;
        }
    } else {
#pragma unroll
      for (int m = 0; m < 4; ++m)
#pragma unroll
        for (int n = 0; n < 4; ++n)
#pragma unroll
          for (int j = 0; j < 4; ++j) {
            int row = rowbase + m * 16 + quad * 4 + j - TX, hc = hc0 + n * 16 + l15;
            P.pchy[(size_t)row * NHYC + hc] = f2bf(acc[m][n][j]);
          }
    }
  }
}
__device__ void phase_gemm_in(const Params& P, int l, char* smem) {
  const int nx = 128 * 47;
  const int nctx = 8 * ((l == 0) ? 47 : 23);
  for (int id = blockIdx.x; id < nx + nctx; id += gridDim.x) {
    int mt, nt;
    if (id < nx) { mt = (id / 376) * 8 + (id & 7); nt = (id % 376) >> 3; }
    else { int i2 = id - nx; mt = 128 + (i2 & 7); nt = i2 >> 3; }
    gemm_in_task(P, l, mt, nt, smem);
  }
}

__device__ void q_gemm_task(const Params& P, int l, int mt, int nt, char* smem) {
  float* rs = (float*)(smem + 65536);
  const int tid = threadIdx.x, lane = tid & 63, w = tid >> 6, wr = w >> 1, wc = w & 1, l15 = lane & 15, quad = lane >> 4;
  const int row0 = mt * 128, col0 = nt * 128;
  for (int rr = 0; rr < 32; ++rr) {
    int r = w * 32 + rr;
    uint4 v = *(const uint4*)(P.pa + (size_t)(row0 + r) * NPA + lane * 8);
    float ss = 0.f;
    unsigned uu[4] = {v.x, v.y, v.z, v.w};
#pragma unroll
    for (int e = 0; e < 4; ++e) { float a = __uint_as_float(uu[e] << 16), b = __uint_as_float(uu[e] & 0xffff0000u); ss += a * a + b * b; }
    ss = wave_sum(ss);
    if (lane == 0) rs[r] = rsqrtf(ss * (1.f / 512.f) + EPSN) * QSCALE;
  }
  __syncthreads();
  f32x4 acc[4][4];
  gemm_tile(P.pa + (size_t)row0 * NPA, NPA, P.wT_uq + (size_t)l * QW * 512 + (size_t)col0 * 512, 512, 512, smem, acc);
  const int rowbase = row0 + wr * 64, colbase = col0 + wc * 64;
  const bool isx = row0 < TX;
  const bool ropet = isx && (((colbase >> 6) % 3) == 2);
#pragma unroll
  for (int m = 0; m < 4; ++m)
#pragma unroll
    for (int j = 0; j < 4; ++j) {
      int row = rowbase + m * 16 + quad * 4 + j;
      float sc = rs[row - row0];
      float v0 = acc[m][0][j] * sc, v1 = acc[m][1][j] * sc, v2 = acc[m][2][j] * sc, v3 = acc[m][3][j] * sc;
      if (ropet) {
        int t = row & 4095;
        float2 cs0 = *(const float2*)(P.rope + 2 * ((t >> 6) * 16 + l15));
        float2 cs1 = *(const float2*)(P.rope + 2 * ((t & 63) * 16 + l15));
        float a0 = v0 * cs0.x - v1 * cs0.y, a1 = v1 * cs0.x + v0 * cs0.y;
        float a2 = v2 * cs1.x - v3 * cs1.y, a3 = v3 * cs1.x + v2 * cs1.y;
        v0 = a0; v1 = a1; v2 = a2; v3 = a3;
      }
      bf16* dst = P.qbuf + (size_t)row * QW + colbase + l15;
      dst[0] = f2bf(v0); dst[16] = f2bf(v1); dst[32] = f2bf(v2); dst[48] = f2bf(v3);
    }
  __syncthreads();
}
__device__ void kv_gemm_task(const Params& P, int l, int mt, int nt, char* smem) {
  float* rs = (float*)(smem + 65536);
  const int tid = threadIdx.x, lane = tid & 63, w = tid >> 6, wr = w >> 1, wc = w & 1, l15 = lane & 15, quad = lane >> 4;
  const int row0 = mt * 128, col0 = nt * 128;
  for (int rr = 0; rr < 32; ++rr) {
    int r = w * 32 + rr;
    uint2 v = *(const uint2*)(P.pa + (size_t)(row0 + r) * NPA + 512 + lane * 4);
    float a0 = __uint_as_float(v.x << 16), a1 = __uint_as_float(v.x & 0xffff0000u), a2 = __uint_as_float(v.y << 16), a3 = __uint_as_float(v.y & 0xffff0000u);
    float ss = wave_sum(a0 * a0 + a1 * a1 + a2 * a2 + a3 * a3);
    if (lane == 0) rs[r] = rsqrtf(ss * (1.f / 256.f) + EPSN);
  }
  __syncthreads();
  f32x4 acc[4][4];
  gemm_tile(P.pa + (size_t)row0 * NPA + 512, NPA, P.wT_ukv + (size_t)l * 2048 * 256 + (size_t)col0 * 256, 256, 256, smem, acc);
  const int rowbase = row0 + wr * 64;
  const int h = nt >> 1;
  int b, kk0;
  if (row0 < TX) { b = row0 >> 12; kk0 = 256 + (rowbase & 4095); }
  else { int rc = rowbase - TX; b = rc >> 8; kk0 = rc & 255; }
  if ((nt & 1) == 0) {
#pragma unroll
    for (int m = 0; m < 4; ++m)
#pragma unroll
      for (int j = 0; j < 4; ++j) {
        int rl = m * 16 + quad * 4 + j;
        float sc = rs[wr * 64 + rl];
        bf16* dst = P.Kn + (((size_t)b * 8 + h) * LK + kk0 + rl) * 128 + wc * 64 + l15;
#pragma unroll
        for (int n = 0; n < 4; ++n) dst[n * 16] = f2bf(acc[m][n][j] * sc);
      }
  } else {
#pragma unroll
    for (int m = 0; m < 4; ++m) {
      int rl = m * 16 + quad * 4;
      float s0 = rs[wr * 64 + rl], s1 = rs[wr * 64 + rl + 1], s2 = rs[wr * 64 + rl + 2], s3 = rs[wr * 64 + rl + 3];
#pragma unroll
      for (int n = 0; n < 4; ++n) {
        int d = wc * 64 + n * 16 + l15;
        uint2 o; o.x = pack2(acc[m][n][0] * s0, acc[m][n][1] * s1); o.y = pack2(acc[m][n][2] * s2, acc[m][n][3] * s3);
        *(uint2*)(P.vT + (((size_t)b * 8 + h) * 128 + d) * LK + kk0 + rl) = o;
      }
    }
  }
  __syncthreads();
}

__device__ __forceinline__ float conv3(const bf16* __restrict__ rowp, int n, float w0, float w1, float w2, float bb) {
  float a = bb + w1 * bf2f(rowp[n]);
  if (n > 0) a += w0 * bf2f(rowp[n - 1]);
  if (n < 4095) a += w2 * bf2f(rowp[n + 1]);
  return a;
}
__device__ void hyena_x_task(const Params& P, int l, int c, char* smem) {
  cf* lds = (cf*)smem;
  cf* est = (cf*)(smem + 34816);
  float* hbx = (float*)(smem + 34816);
  float* w3s = (float*)(smem + 34816 + 32768);
  const int t = launder(threadIdx.x);
  FftTw tw;
  tw.c1 = cispi(-(float)t / 2048.f);
  tw.c2 = cispi(-(float)(t & 15) / 128.f);
  tw.c4 = cispi(-(float)((t & 15) * (t >> 4)) / 2048.f);
  tw.c5 = cispi(-(float)(t >> 4) / 128.f);
  const cf c8 = cispi(-(float)t / 4096.f);
  const cf w32 = cf{0.98078528040323043f, -0.19509032201612825f};
  if (t < 128) w3s[t] = P.filt_w3[((size_t)l * 64 + (t & 63)) * 2048 + (t >> 6) * 1024 + c];
  __syncthreads();
  cf* kfe = (cf*)P.kfg + (size_t)blockIdx.x * 8192;
  cf* kfo = kfe + 4096;
  {
    cf ke[16];
    float af[16], ab[16];
#pragma unroll
    for (int j = 0; j < 16; ++j) { af[j] = 0.f; ab[j] = 0.f; }
    const float* h2p = P.h2T + (size_t)l * 64 * 4096;
#pragma unroll 1
    for (int i = 0; i < 64; ++i) {
      float wf = w3s[i], wb = w3s[64 + i];
#pragma unroll
      for (int j = 0; j < 16; ++j) { float hv = h2p[i * 4096 + j * 256 + t]; af[j] += hv * wf; ab[j] += hv * wb; }
    }
    const float d0 = -15.350567286626973f, d1 = -3.0701134573253946f;
    const float adel = fabsf(d0 + (float)c * ((d1 - d0) / 1023.f));
#pragma unroll
    for (int j = 0; j < 16; ++j) {
      int n = 256 * j + t;
      float dec = expf(-((float)n * (1.f / 4095.f)) * adel);
      af[j] *= dec; ab[j] *= dec;
      hbx[n] = ab[j];
    }
    __syncthreads();
#pragma unroll
    for (int j = 0; j < 16; ++j) {
      int n = 256 * j + t;
      float k1 = (n == 0) ? 0.f : hbx[4096 - n];
      ke[j] = cf{af[j] + k1, 0.f};
      af[j] = af[j] - k1;
    }
    __syncthreads();
    fft_fwd(ke, t, tw, lds);
    { const int tl = launder(t); _Pragma("unroll") for (int r = 0; r < 16; ++r) kfe[r * 256 + tl] = ke[r]; }
    cf wn = cf{launderf(c8.x), launderf(c8.y)};
#pragma unroll
    for (int j = 0; j < 16; ++j) { ke[j] = cf{af[j] * wn.x, af[j] * wn.y}; wn = cmul(wn, w32); }
    fft_fwd(ke, t, tw, lds);
    { const int tl = launder(t); _Pragma("unroll") for (int r = 0; r < 16; ++r) kfo[r * 256 + tl] = ke[r]; }
  }
  const float cw10 = P.conv_w[(l * 3 + 0) * 3072 + 1024 + c], cw11 = P.conv_w[(l * 3 + 1) * 3072 + 1024 + c], cw12 = P.conv_w[(l * 3 + 2) * 3072 + 1024 + c];
  const float cwv0 = P.conv_w[(l * 3 + 0) * 3072 + 2048 + c], cwv1 = P.conv_w[(l * 3 + 1) * 3072 + 2048 + c], cwv2 = P.conv_w[(l * 3 + 2) * 3072 + 2048 + c];
  const float cw00 = P.conv_w[(l * 3 + 0) * 3072 + c], cw01 = P.conv_w[(l * 3 + 1) * 3072 + c], cw02 = P.conv_w[(l * 3 + 2) * 3072 + c];
  const float cb0 = P.conv_b[l * 3072 + c], cb1 = P.conv_b[l * 3072 + 1024 + c], cbv = P.conv_b[l * 3072 + 2048 + c];
  const float Dc = P.hy_D[l * 1024 + c];
  for (int pr = 0; pr < 2; ++pr) {
    const int b0 = 2 * pr, b1 = 2 * pr + 1;
    const bf16* p1a = P.pT + ((size_t)b0 * NHYC + 1024 + c) * 4096;
    const bf16* pva = P.pT + ((size_t)b0 * NHYC + 2048 + c) * 4096;
    const bf16* p1b = P.pT + ((size_t)b1 * NHYC + 1024 + c) * 4096;
    const bf16* pvb = P.pT + ((size_t)b1 * NHYC + 2048 + c) * 4096;
    cf x[16];
#pragma unroll 1
    for (int j = 0; j < 16; ++j) {
      int n = 256 * j + t;
      float ua = conv3(p1a, n, cw10, cw11, cw12, cb1) * conv3(pva, n, cwv0, cwv1, cwv2, cbv);
      float ub = conv3(p1b, n, cw10, cw11, cw12, cb1) * conv3(pvb, n, cwv0, cwv1, cwv2, cbv);
      lds[(t + (t >> 4)) + 272 * j] = cf{ua, ub};
    }
#pragma unroll
    for (int j = 0; j < 16; ++j) x[j] = lds[(t + (t >> 4)) + 272 * j];
    fft_fwd(x, t, tw, lds);
    { const int tl = launder(t); _Pragma("unroll") for (int r = 0; r < 16; ++r) x[r] = cmul(x[r], kfe[r * 256 + tl]); }
    fft_inv(x, t, tw, lds);
#pragma unroll
    for (int j = 0; j < 16; ++j) est[256 * j + t] = x[j];
    {
      cf wn = cf{launderf(c8.x), launderf(c8.y)};
#pragma unroll 1
      for (int j = 0; j < 16; ++j) {
        int n = 256 * j + t;
        float ua = conv3(p1a, n, cw10, cw11, cw12, cb1) * conv3(pva, n, cwv0, cwv1, cwv2, cbv);
        float ub = conv3(p1b, n, cw10, cw11, cw12, cb1) * conv3(pvb, n, cwv0, cwv1, cwv2, cbv);
        lds[(t + (t >> 4)) + 272 * j] = cmul(cf{ua, ub}, wn);
        wn = cmul(wn, w32);
      }
    }
#pragma unroll
    for (int j = 0; j < 16; ++j) x[j] = lds[(t + (t >> 4)) + 272 * j];
    fft_fwd(x, t, tw, lds);
    { const int tl = launder(t); _Pragma("unroll") for (int r = 0; r < 16; ++r) x[r] = cmul(x[r], kfo[r * 256 + tl]); }
    fft_inv(x, t, tw, lds);
    {
      cf wn = cf{launderf(c8.x), launderf(c8.y)};
#pragma unroll
      for (int j = 0; j < 16; ++j) {
        int n = 256 * j + t;
        cf o = cmulc(x[j], wn);
        cf e = est[n];
        est[n] = cf{(e.x + o.x) * (1.f / 8192.f), (e.y + o.y) * (1.f / 8192.f)};
        wn = cmul(wn, w32);
      }
    }
    const bf16* p0a = P.pT + ((size_t)b0 * NHYC + c) * 4096;
    const bf16* p0b = P.pT + ((size_t)b1 * NHYC + c) * 4096;
    bf16* oa = P.yhT + ((size_t)b0 * 1024 + c) * 4096;
    bf16* ob = P.yhT + ((size_t)b1 * 1024 + c) * 4096;
#pragma unroll 1
    for (int j = 0; j < 16; ++j) {
      int n = 256 * j + t;
      cf y = est[n];
      float ua = conv3(p1a, n, cw10, cw11, cw12, cb1) * conv3(pva, n, cwv0, cwv1, cwv2, cbv);
      float ub = conv3(p1b, n, cw10, cw11, cw12, cb1) * conv3(pvb, n, cwv0, cwv1, cwv2, cbv);
      float xa = conv3(p0a, n, cw00, cw01, cw02, cb0), xb = conv3(p0b, n, cw00, cw01, cw02, cb0);
      oa[n] = f2bf(xa * (y.x + Dc * ua));
      ob[n] = f2bf(xb * (y.y + Dc * ub));
    }
  }
  __syncthreads();
}
__device__ void hyena_ctx_task(const Params& P, int c, char* smem) {
  float* hf = (float*)smem;
  float* hb = hf + 256;
  float* us = hb + 256;
  const int t = launder(threadIdx.x);
  const int l = 0;
  float af = 0.f, ab = 0.f;
  for (int i = 0; i < 64; ++i) {
    float hv = P.h2cT[i * 256 + t];
    af += hv * P.filt_w3[((size_t)l * 64 + i) * 2048 + c];
    ab += hv * P.filt_w3[((size_t)l * 64 + i) * 2048 + 1024 + c];
  }
  const float d0 = -15.350567286626973f, d1 = -3.0701134573253946f;
  const float adel = fabsf(d0 + (float)c * ((d1 - d0) / 1023.f));
  float dec = expf(-((float)t / 255.f) * adel);
  hf[t] = af * dec; hb[t] = ab * dec;
  float x0c[4], uu[4];
#pragma unroll
  for (int b = 0; b < 4; ++b) {
    const bf16* base = P.pchy + (size_t)(b * 256) * NHYC;
    float cv[3];
#pragma unroll
    for (int g = 0; g < 3; ++g) {
      int col = g * 1024 + c;
      float a = P.conv_b[l * 3072 + col] + P.conv_w[(l * 3 + 1) * 3072 + col] * bf2f(base[(size_t)t * NHYC + col]);
      if (t > 0) a += P.conv_w[(l * 3 + 0) * 3072 + col] * bf2f(base[(size_t)(t - 1) * NHYC + col]);
      if (t < 255) a += P.conv_w[(l * 3 + 2) * 3072 + col] * bf2f(base[(size_t)(t + 1) * NHYC + col]);
      cv[g] = a;
    }
    x0c[b] = cv[0]; uu[b] = cv[1] * cv[2];
    us[b * 256 + t] = uu[b];
  }
  __syncthreads();
  float acc[4] = {0.f, 0.f, 0.f, 0.f};
  for (int s = 0; s < 256; ++s) {
    float k = (s <= t) ? hf[t - s] : hb[s - t];
#pragma unroll
    for (int b = 0; b < 4; ++b) acc[b] += k * us[b * 256 + s];
  }
  const float Dc = P.hy_D[l * 1024 + c];
#pragma unroll
  for (int b = 0; b < 4; ++b) {
    int row = TX + b * 256 + t;
    P.xh[(size_t)row * 2048 + 1024 + c] = f2bf(x0c[b] * (acc[b] + Dc * uu[b]));
  }
  __syncthreads();
}
__device__ void phase_d(const Params& P, int l, char* smem) {
  const int nhx = 1024, nhc = (l == 0) ? 1024 : 0;
  const int nqm = (l == 0) ? 136 : 128;
  const int nq = nqm * 12, nkv = 136 * 16;
  const int total = nhx + nhc + nq + nkv;
  for (int id = blockIdx.x; id < total; id += gridDim.x) {
    int i = id;
#ifndef PDM
#define PDM 15
#endif
    if (i < nhx) { if (PDM & 1) hyena_x_task(P, l, i, smem); continue; }
    i -= nhx;
    if (i < nhc) { if (PDM & 2) hyena_ctx_task(P, i, smem); continue; }
    i -= nhc;
    if (i < nq) { if (PDM & 4) q_gemm_task(P, l, i / 12, i % 12, smem); continue; }
    i -= nq;
    if (PDM & 8) kv_gemm_task(P, l, i >> 4, i & 15, smem);
  }
}

__device__ void attn_task(const Params& P, int b, int h, int qrow0, int nkt, char* smem) {
  char* Ks = smem;
  char* Vs = smem + 25600;
  const int tid = launder(threadIdx.x), lane = tid & 63, w = tid >> 6, l15 = lane & 15, quad = lane >> 4;
  bf16x8 qf[2][6];
#pragma unroll
  for (int m = 0; m < 2; ++m)
#pragma unroll
    for (int ks = 0; ks < 6; ++ks)
      qf[m][ks] = *(const bf16x8*)(P.qbuf + (size_t)(qrow0 + w * 32 + m * 16 + l15) * QW + h * 192 + ks * 32 + quad * 8);
  const bf16* Kg = P.Kn + ((size_t)b * 8 + h) * LK * 128;
  const bf16* Rg = P.kr + (size_t)b * LK * 64;
  const bf16* Vg = P.vT + ((size_t)b * 8 + h) * 128 * LK;
  uint4 sk[4], sr[2], sv[4];
  auto gload = [&](int kt) {
#pragma unroll
    for (int q = 0; q < 4; ++q) { int id = tid + 256 * q; int key = id >> 4, ch = id & 15; sk[q] = *(const uint4*)(Kg + (size_t)(kt * 64 + key) * 128 + ch * 8); }
#pragma unroll
    for (int q = 0; q < 2; ++q) { int id = tid + 256 * q; int key = id >> 3, ch = id & 7; sr[q] = *(const uint4*)(Rg + (size_t)(kt * 64 + key) * 64 + ch * 8); }
#pragma unroll
    for (int q = 0; q < 4; ++q) { int id = tid + 256 * q; int d = id >> 3, ch = id & 7; sv[q] = *(const uint4*)(Vg + (size_t)d * LK + kt * 64 + ch * 8); }
  };
  auto lstore = [&]() {
#pragma unroll
    for (int q = 0; q < 4; ++q) { int id = tid + 256 * q; int key = id >> 4, ch = id & 15; *(uint4*)(Ks + key * 400 + ch * 16) = sk[q]; }
#pragma unroll
    for (int q = 0; q < 2; ++q) { int id = tid + 256 * q; int key = id >> 3, ch = id & 7; *(uint4*)(Ks + key * 400 + 256 + ch * 16) = sr[q]; }
#pragma unroll
    for (int q = 0; q < 4; ++q) { int id = tid + 256 * q; int d = id >> 3, ch = id & 7; *(uint4*)(Vs + d * 144 + ch * 16) = sv[q]; }
  };
  f32x4 oacc[8][2];
#pragma unroll
  for (int nd = 0; nd < 8; ++nd) { oacc[nd][0] = f32x4{0.f, 0.f, 0.f, 0.f}; oacc[nd][1] = f32x4{0.f, 0.f, 0.f, 0.f}; }
  float mrow[2] = {-1e30f, -1e30f}, lrow[2] = {0.f, 0.f};
  gload(0);
  lstore();
  __syncthreads();
  for (int kt = 0; kt < nkt; ++kt) {
    f32x4 s[4][2];
#pragma unroll
    for (int n = 0; n < 4; ++n) { s[n][0] = f32x4{0.f, 0.f, 0.f, 0.f}; s[n][1] = f32x4{0.f, 0.f, 0.f, 0.f}; }
#pragma unroll
    for (int ks = 0; ks < 6; ++ks) {
#pragma unroll
      for (int n = 0; n < 4; ++n) {
        bf16x8 a = *(const bf16x8*)(Ks + (n * 16 + l15) * 400 + ks * 64 + quad * 16);
        s[n][0] = __builtin_amdgcn_mfma_f32_16x16x32_bf16(a, qf[0][ks], s[n][0], 0, 0, 0);
        s[n][1] = __builtin_amdgcn_mfma_f32_16x16x32_bf16(a, qf[1][ks], s[n][1], 0, 0, 0);
      }
      if (ks & 1) __builtin_amdgcn_sched_barrier(0);
    }
    bf16x8 pb[2][2];
#pragma unroll
    for (int m = 0; m < 2; ++m) {
      float mx = s[0][m][0];
#pragma unroll
      for (int n = 0; n < 4; ++n)
#pragma unroll
        for (int j = 0; j < 4; ++j) mx = fmaxf(mx, s[n][m][j]);
      mx = fmaxf(mx, __shfl_xor(mx, 16));
      mx = fmaxf(mx, __shfl_xor(mx, 32));
      float mn = fmaxf(mrow[m], mx);
      float alpha = exp2f(mrow[m] - mn);
      mrow[m] = mn;
      float ps = 0.f;
#pragma unroll
      for (int n = 0; n < 4; ++n)
#pragma unroll
        for (int j = 0; j < 4; ++j) { float p = exp2f(s[n][m][j] - mn); s[n][m][j] = p; ps += p; }
      lrow[m] = lrow[m] * alpha + ps;
#pragma unroll
      for (int nd = 0; nd < 8; ++nd) { oacc[nd][m][0] *= alpha; oacc[nd][m][1] *= alpha; oacc[nd][m][2] *= alpha; oacc[nd][m][3] *= alpha; }
#pragma unroll
      for (int k2 = 0; k2 < 2; ++k2) {
        uint4 pk;
        pk.x = pack2(s[2 * k2][m][0], s[2 * k2][m][1]); pk.y = pack2(s[2 * k2][m][2], s[2 * k2][m][3]);
        pk.z = pack2(s[2 * k2 + 1][m][0], s[2 * k2 + 1][m][1]); pk.w = pack2(s[2 * k2 + 1][m][2], s[2 * k2 + 1][m][3]);
        pb[m][k2] = *(bf16x8*)&pk;
      }
    }
    __builtin_amdgcn_sched_barrier(0);
#pragma unroll
    for (int nd = 0; nd < 8; ++nd) {
      if ((nd & 1) == 0) __builtin_amdgcn_sched_barrier(0);
#pragma unroll
      for (int k2 = 0; k2 < 2; ++k2) {
        const char* vp = Vs + (nd * 16 + l15) * 144 + k2 * 64 + quad * 8;
        uint2 lo = *(const uint2*)(vp), hi = *(const uint2*)(vp + 32);
        uint4 av = uint4{lo.x, lo.y, hi.x, hi.y};
        bf16x8 a = *(bf16x8*)&av;
        oacc[nd][0] = __builtin_amdgcn_mfma_f32_16x16x32_bf16(a, pb[0][k2], oacc[nd][0], 0, 0, 0);
        oacc[nd][1] = __builtin_amdgcn_mfma_f32_16x16x32_bf16(a, pb[1][k2], oacc[nd][1], 0, 0, 0);
      }
    }
    __syncthreads();
    if (kt + 1 < nkt) { gload(kt + 1); lstore(); }
    __syncthreads();
  }
#pragma unroll
  for (int m = 0; m < 2; ++m) {
    float lt = lrow[m];
    lt += __shfl_xor(lt, 16);
    lt += __shfl_xor(lt, 32);
    float inv = 1.f / lt;
    int row = qrow0 + w * 32 + m * 16 + l15;
#pragma unroll
    for (int nd = 0; nd < 8; ++nd) {
      uint2 o; o.x = pack2(oacc[nd][m][0] * inv, oacc[nd][m][1] * inv); o.y = pack2(oacc[nd][m][2] * inv, oacc[nd][m][3] * inv);
      *(uint2*)(P.xh + (size_t)row * 2048 + h * 128 + nd * 16 + quad * 4) = o;
    }
  }
}
__device__ void phase_attn(const Params& P, int l, char* smem) {
  const int nx = 1024, nc = (l == 0) ? 64 : 0;
  for (int id = blockIdx.x; id < nx + nc; id += gridDim.x) {
    if (id < nx) {
      int j = id >> 3;
      int bh = (id & 7) + 8 * (j >> 5), qt = j & 31;
      int b = bh >> 3, h = bh & 7;
      attn_task(P, b, h, b * 4096 + qt * 128, 68, smem);
    } else {
      int i = id - nx;
      int bh = i >> 1, qt = i & 1;
      int b = bh >> 3, h = bh & 7;
      attn_task(P, b, h, TX + b * 256 + qt * 128, 4, smem);
    }
  }
}

__device__ __forceinline__ void unpack8(uint4 v, float* f) {
  f[0] = __uint_as_float(v.x << 16); f[1] = __uint_as_float(v.x & 0xffff0000u);
  f[2] = __uint_as_float(v.y << 16); f[3] = __uint_as_float(v.y & 0xffff0000u);
  f[4] = __uint_as_float(v.z << 16); f[5] = __uint_as_float(v.z & 0xffff0000u);
  f[6] = __uint_as_float(v.w << 16); f[7] = __uint_as_float(v.w & 0xffff0000u);
}
__device__ __forceinline__ void merge_row(const Params& P, int row, const char* yh_lds  , int lane) {
  bf16* yr = P.xh + (size_t)row * 2048;
  const bf16* gr = P.pa + (size_t)row * NPA;
  float o[2][8], y[2][8];
  float so = 0.f, sy = 0.f;
#pragma unroll
  for (int i = 0; i < 2; ++i) {
    int col = i * 512 + lane * 8;
    unpack8(*(const uint4*)(yr + col), o[i]);
    uint4 yv = yh_lds ? *(const uint4*)(yh_lds + col * 2) : *(const uint4*)(yr + 1024 + col);
    unpack8(yv, y[i]);
#pragma unroll
    for (int e = 0; e < 8; ++e) { so += o[i][e] * o[i][e]; sy += y[i][e] * y[i][e]; }
  }
  so = wave_sum(so); sy = wave_sum(sy);
  float rm = rsqrtf(so * (1.f / 1024.f) + EPSN), rh = rsqrtf(sy * (1.f / 1024.f) + EPSN);
#pragma unroll
  for (int i = 0; i < 2; ++i) {
    int col = i * 512 + lane * 8;
    float gm[8], gh[8];
    unpack8(*(const uint4*)(gr + 832 + col), gm);
    unpack8(*(const uint4*)(gr + 1856 + col), gh);
    uint4 a, b;
    a.x = pack2(o[i][0] * rm * siluf(gm[0]), o[i][1] * rm * siluf(gm[1]));
    a.y = pack2(o[i][2] * rm * siluf(gm[2]), o[i][3] * rm * siluf(gm[3]));
    a.z = pack2(o[i][4] * rm * siluf(gm[4]), o[i][5] * rm * siluf(gm[5]));
    a.w = pack2(o[i][6] * rm * siluf(gm[6]), o[i][7] * rm * siluf(gm[7]));
    b.x = pack2(y[i][0] * rh * siluf(gh[0]), y[i][1] * rh * siluf(gh[1]));
    b.y = pack2(y[i][2] * rh * siluf(gh[2]), y[i][3] * rh * siluf(gh[3]));
    b.z = pack2(y[i][4] * rh * siluf(gh[4]), y[i][5] * rh * siluf(gh[5]));
    b.w = pack2(y[i][6] * rh * siluf(gh[6]), y[i][7] * rh * siluf(gh[7]));
    *(uint4*)(yr + col) = a;
    *(uint4*)(yr + 1024 + col) = b;
  }
}
__device__ void merge_x_task(const Params& P, int task, char* smem) {
  const int tid = threadIdx.x, lane = tid & 63, w = tid >> 6;
  const int b = task >> 7, tt = task & 127;
  constexpr int RS = 2064;
#pragma unroll 4
  for (int i = 0; i < 16; ++i) {
    int id = tid + 256 * i, cch = id >> 2, q = id & 3;
    uint4 v = *(const uint4*)(P.yhT + ((size_t)b * 1024 + cch) * 4096 + tt * 32 + q * 8);
    unsigned uu[4] = {v.x, v.y, v.z, v.w};
#pragma unroll
    for (int e = 0; e < 4; ++e) {
      *(bf16*)(smem + (q * 8 + 2 * e) * RS + cch * 2) = (bf16)(uu[e] & 0xffffu);
      *(bf16*)(smem + (q * 8 + 2 * e + 1) * RS + cch * 2) = (bf16)(uu[e] >> 16);
    }
  }
  __syncthreads();
  for (int rr = 0; rr < 8; ++rr) {
    int tk = w * 8 + rr;
    merge_row(P, b * 4096 + tt * 32 + tk, smem + tk * RS, lane);
  }
  __syncthreads();
}
__device__ void phase_merge(const Params& P, int l, char* smem) {
  const int nx = 512, nc = (l == 0) ? 256 : 0, nw = (l == 0) ? 3008 : 0;
  for (int id = blockIdx.x; id < nx + nc + nw; id += gridDim.x) {
    if (id < nx) merge_x_task(P, id, smem);
    else if (id < nx + nc) { int row = TX + (id - nx) * 4 + (threadIdx.x >> 6); merge_row(P, row, nullptr, threadIdx.x & 63); }
    else win_transpose_task(P, 1, id - nx - nc, smem);
  }
}

__device__ void phase_gemm_out(const Params& P, int l, char* smem) {
  const int nm = (l == 0) ? 136 : 128;
  for (int id = blockIdx.x; id < nm * 16; id += gridDim.x) {
    int mt = (id / 128) * 8 + (id & 7), nt = (id & 127) >> 3;
    f32x4 acc[4][4];
    const int row0 = mt * 128, col0 = nt * 128;
    gemm_tile(P.xh + (size_t)row0 * DM, DM, P.wT_out + (size_t)l * DM * DM + (size_t)col0 * DM, DM, DM, smem, acc);
    const int tid = threadIdx.x, lane = tid & 63, w = tid >> 6, wr = w >> 1, wc = w & 1, l15 = lane & 15, quad = lane >> 4;
#pragma unroll
    for (int m = 0; m < 4; ++m)
#pragma unroll
      for (int n = 0; n < 4; ++n)
#pragma unroll
        for (int j = 0; j < 4; ++j) {
          int row = row0 + wr * 64 + m * 16 + quad * 4 + j, col = col0 + wc * 64 + n * 16 + l15;
          P.z[(size_t)row * 2048 + col] = acc[m][n][j];
        }
  }
}

__device__ void phase_a(const Params& P, char* smem) {
  const int n0 = 192, n1 = n0 + 2112, n2 = n1 + 1, n3 = n2 + 3008, n4 = n3 + 384, n5 = n4 + 256, n6 = n5 + 2048;
  for (int id = blockIdx.x; id < n6; id += gridDim.x) {
    if (id < n0) modulation_task(P, id, smem);
    else if (id < n1) h2_task(P, id - n0, smem);
    else if (id < n2) rope_table_task(P);
    else if (id < n3) win_transpose_task(P, 0, id - n2, smem);
    else if (id < n4) {
      int i = id - n3, l = i / 192, r = i % 192, nt = r >> 3, kt = r & 7;
      transpose_tile(P.w_uq + (size_t)l * 512 * QW, QW, kt * 64, nt * 64, P.wT_uq + (size_t)l * QW * 512, 512, nt * 64, P.q_norm_g + l * 512, false, smem);
    } else if (id < n5) {
      int i = id - n4, l = i / 128, r = i % 128, nt = r >> 2, kt = r & 3;
      transpose_tile(P.w_ukv + (size_t)l * 256 * 2048, 2048, kt * 64, nt * 64, P.wT_ukv + (size_t)l * 2048 * 256, 256, nt * 64, P.kv_norm_g + l * 256, false, smem);
    } else {
      int i = id - n5, l = i / 1024, r = i % 1024, nt = r >> 5, kt = r & 31;
      const float* gk = (kt < 16) ? (P.grp_g_mla + l * 1024) : (P.grp_g_hy + l * 1024 - 1024);
      transpose_tile(P.w_out + (size_t)l * DM * DM, DM, kt * 64, nt * 64, P.wT_out + (size_t)l * DM * DM, DM, nt * 64, gk, false, smem);
    }
  }
}

#ifndef MINB
#define MINB 1
#endif
__global__ void __launch_bounds__(256, MINB) hymba_fwd(Params Pin) {
  extern __shared__ __attribute__((aligned(16))) char smem[];
  cg::grid_group grid = cg::this_grid();
#ifndef PM
#define PM 0xffff
#endif
  typedef const Params __attribute__((address_space(4))) * KP4;
#if defined(__HIP_DEVICE_COMPILE__)
#define GETP() ([&]() { KP4 kp = (KP4)__builtin_amdgcn_kernarg_segment_ptr(); asm volatile("" : "+s"(kp)); Params q = *kp; return q; }())
#else
#define GETP() Pin
#endif
  if (PM & 1) phase_a(GETP(), smem);
  grid.sync();
  if (PM & 2) phase_prenorm0(GETP());
  grid.sync();
#pragma unroll 1
  for (int l = 0; l < 2; ++l) {
    if (PM & 4) phase_gemm_in(GETP(), l, smem);
    grid.sync();
    if (PM & 8) phase_d(GETP(), l, smem);
    grid.sync();
    if (PM & 16) phase_attn(GETP(), l, smem);
    grid.sync();
    if (PM & 32) phase_merge(GETP(), l, smem);
    grid.sync();
    if (PM & 64) phase_gemm_out(GETP(), l, smem);
    grid.sync();
    if (PM & 128) phase_post(GETP(), l);
    if (l == 0) grid.sync();
  }
}

extern "C" void kernel_launch(void* const* d_in, const int* in_sizes, int n_in, void* d_out, int out_size, void* d_ws, size_t ws_size,
                              hipStream_t stream) {
  static int grid_blocks = 0;
  if (grid_blocks == 0) {
    int dev = 0, cus = 0, per_cu = 0;
    hipGetDevice(&dev);
    hipDeviceGetAttribute(&cus, hipDeviceAttributeMultiprocessorCount, dev);
    if (hipFuncSetAttribute((const void*)hymba_fwd, hipFuncAttributeMaxDynamicSharedMemorySize, LDS_BYTES) != hipSuccess) {
      fprintf(stderr, "hipFuncSetAttribute failed\n"); grid_blocks = -1; return;
    }
    hipOccupancyMaxActiveBlocksPerMultiprocessor(&per_cu, (const void*)hymba_fwd, NT, LDS_BYTES);
    if (per_cu < 1) per_cu = 1;
    if (per_cu > 2) per_cu = 2;
    grid_blocks = cus * per_cu;
  }
  if (grid_blocks < 0) return;
  Params p{};
  const float** pin = (const float**)&p;
  for (int i = 0; i < 25; ++i) pin[i] = (const float*)d_in[i];
  p.out = (float*)d_out;
  char* ws = (char*)d_ws;
  size_t off = 0;
  auto take = [&](size_t bytes) { char* r = ws + off; off += (bytes + 255) & ~(size_t)255; return r; };
  p.wT_in = (bf16*)take((size_t)NPADW * DM * 2);
  p.wT_uq = (bf16*)take((size_t)2 * QW * 512 * 2);
  p.wT_ukv = (bf16*)take((size_t)2 * 2048 * 256 * 2);
  p.wT_out = (bf16*)take((size_t)2 * DM * DM * 2);
  p.mod = (float*)take((size_t)2 * 5 * 6144 * 4);
  p.h2T = (float*)take((size_t)2 * 64 * 4096 * 4);
  p.h2cT = (float*)take((size_t)64 * 256 * 4);
  p.rope = (float*)take((size_t)64 * 16 * 2 * 4);
  p.xh = (bf16*)take((size_t)TT * DM * 2);
  p.pa = (bf16*)take((size_t)TT * NPA * 2);
  p.pT = (bf16*)take((size_t)4 * NHYC * 4096 * 2);
  p.pchy = (bf16*)take((size_t)TC * NHYC * 2);
  p.z = (float*)p.pa;
  p.qbuf = (bf16*)take((size_t)TT * QW * 2);
  p.Kn = (bf16*)take((size_t)4 * 8 * LK * 128 * 2);
  p.kr = (bf16*)take((size_t)4 * LK * 64 * 2);
  p.vT = (bf16*)take((size_t)4 * 8 * 128 * LK * 2);
  p.yhT = (bf16*)take((size_t)4 * 1024 * 4096 * 2);
  p.ctx1 = (float*)take((size_t)TC * DM * 4);
  p.kfg = (float*)take((size_t)grid_blocks * 2 * 4096 * 8);
  if (off > ws_size) { fprintf(stderr, "workspace too small: need %zu have %zu\n", off, ws_size); return; }
  void* args[] = {&p};
  hipError_t e = hipLaunchCooperativeKernel((void*)hymba_fwd, dim3(grid_blocks), dim3(NT), args, LDS_BYTES, stream);
  if (e != hipSuccess) fprintf(stderr, "cooperative launch failed: %s (grid %d)\n", hipGetErrorString(e), grid_blocks);
}
```

```cpp
#include <hip/hip_runtime.h>
#include <hip/hip_cooperative_groups.h>
#include <cstdio>
namespace cg = cooperative_groups;

typedef unsigned short bf16;
using bf16x8 = __attribute__((ext_vector_type(8))) short;
using f32x4 = __attribute__((ext_vector_type(4))) float;

constexpr int DM = 2048, SEQ = 4096, CTXL = 256;
constexpr int TX = 16384, TC = 1024, TT = 17408;
constexpr int NIN = 5952, NPA = 2944, NHYC = 3072, NPADW = 6016;
constexpr int LK = 4352;
constexpr int QW = 1536;
constexpr float EPSN = 1e-6f;
constexpr float QSCALE = 0.07216878364870322f * 1.4426950408889634f;
constexpr int LDS_BYTES = 69632;
constexpr int NT = 256;

struct Params {
  const float *x, *c, *ctx, *c_ctx, *ada_w, *ada_b, *pre_g, *w_in, *q_norm_g, *w_uq, *kv_norm_g, *w_ukv, *conv_w, *conv_b,
      *filt_w1, *filt_b1, *filt_freq, *filt_w2, *filt_b2, *filt_w3, *hy_D, *grp_g_mla, *grp_g_hy, *w_out, *post_g;
  float* out;
  bf16 *wT_in, *wT_uq, *wT_ukv, *wT_out;
  float *mod, *h2T, *h2cT, *rope;
  bf16 *xh, *pa, *pT, *pchy;
  float* z;
  bf16 *qbuf, *Kn, *kr, *vT, *yhT;
  float* ctx1;
  float* kfg;
  int reps[8];
};

__device__ __forceinline__ bf16 f2bf(float f) {
  unsigned u = __float_as_uint(f);
  u += 0x7fffu + ((u >> 16) & 1u);
  return (bf16)(u >> 16);
}
__device__ __forceinline__ float bf2f(bf16 h) { return __uint_as_float(((unsigned)h) << 16); }
__device__ __forceinline__ unsigned pack2(float a, float b) { return (unsigned)f2bf(a) | ((unsigned)f2bf(b) << 16); }
__device__ __forceinline__ float wave_sum(float v) {
#pragma unroll
  for (int o = 32; o > 0; o >>= 1) v += __shfl_xor(v, o);
  return v;
}
__device__ __forceinline__ int launder(int v) { asm volatile("" : "+v"(v)); return v; }
__device__ __forceinline__ float launderf(float v) { asm volatile("" : "+v"(v)); return v; }
__device__ __forceinline__ float siluf(float v) { return v / (1.f + __expf(-v)); }

#define HD __device__ __forceinline__
struct cf { float x, y; };
HD cf cmul(cf a, cf b) { return cf{a.x * b.x - a.y * b.y, a.x * b.y + a.y * b.x}; }
HD cf cmulc(cf a, cf b) { return cf{a.x * b.x + a.y * b.y, a.y * b.x - a.x * b.y}; }
HD cf cadd(cf a, cf b) { return cf{a.x + b.x, a.y + b.y}; }
HD cf csub(cf a, cf b) { return cf{a.x - b.x, a.y - b.y}; }
template <bool INV> HD void dft4(cf& a0, cf& a1, cf& a2, cf& a3) {
  cf s02 = cadd(a0, a2), d02 = csub(a0, a2), s13 = cadd(a1, a3), d13 = csub(a1, a3);
  cf r = INV ? cf{-d13.y, d13.x} : cf{d13.y, -d13.x};
  a0 = cadd(s02, s13); a2 = csub(s02, s13); a1 = cadd(d02, r); a3 = csub(d02, r);
}
#define W16C1 0.92387953251128674f
#define W16S1 0.38268343236508977f
#define W16R2 0.70710678118654752f
template <bool INV> HD cf w16(int m) {
  float c, s;
  switch (m) {
    case 0: c = 1.f; s = 0.f; break;
    case 1: c = W16C1; s = W16S1; break;
    case 2: c = W16R2; s = W16R2; break;
    case 3: c = W16S1; s = W16C1; break;
    case 4: c = 0.f; s = 1.f; break;
    case 6: c = -W16R2; s = W16R2; break;
    default: c = -W16C1; s = -W16S1; break;
  }
  return cf{c, INV ? s : -s};
}
template <bool INV> HD void dft16_nt(cf* x) {
#pragma unroll
  for (int b = 0; b < 4; ++b) dft4<INV>(x[b], x[4 + b], x[8 + b], x[12 + b]);
#pragma unroll
  for (int c = 1; c < 4; ++c)
#pragma unroll
    for (int b = 1; b < 4; ++b) x[4 * c + b] = cmul(x[4 * c + b], w16<INV>(b * c));
#pragma unroll
  for (int c = 0; c < 4; ++c) dft4<INV>(x[4 * c], x[4 * c + 1], x[4 * c + 2], x[4 * c + 3]);
}
template <bool INV> HD void dft16_tn(cf* x) {
#pragma unroll
  for (int c = 0; c < 4; ++c) dft4<INV>(x[4 * c], x[4 * c + 1], x[4 * c + 2], x[4 * c + 3]);
#pragma unroll
  for (int c = 1; c < 4; ++c)
#pragma unroll
    for (int b = 1; b < 4; ++b) x[4 * c + b] = cmul(x[4 * c + b], w16<INV>(b * c));
#pragma unroll
  for (int b = 0; b < 4; ++b) dft4<INV>(x[b], x[4 + b], x[8 + b], x[12 + b]);
}
#define KOF(r) (((r) >> 2) + 4 * ((r) & 3))
#define PADI(p) ((p) + ((p) >> 4))
struct FftTw { cf c1, c2, c4, c5; };
HD void fwd_p1(cf* x, int t, const FftTw& tw, cf* lds) {
  dft16_nt<false>(x);
  __builtin_amdgcn_sched_barrier(0);
  cf pw = cf{1.f, 0.f};
#pragma unroll
  for (int k = 0; k < 16; ++k) { lds[(t + (t >> 4)) + 272 * k] = cmul(x[KOF(k)], pw); pw = cmul(pw, tw.c1); if ((k & 3) == 3) __builtin_amdgcn_sched_barrier(0); }
}
HD void fwd_p2(cf* x, int t, const FftTw& tw, cf* lds) {
  int k1 = t >> 4, n2b = t & 15;
#pragma unroll
  for (int j = 0; j < 16; ++j) x[j] = lds[(272 * k1 + n2b) + 17 * j];
  __builtin_amdgcn_sched_barrier(0);
  dft16_nt<false>(x);
  __builtin_amdgcn_sched_barrier(0);
  cf pw = cf{1.f, 0.f};
#pragma unroll
  for (int k = 0; k < 16; ++k) { lds[(272 * k1 + n2b) + 17 * k] = cmul(x[KOF(k)], pw); pw = cmul(pw, tw.c2); __builtin_amdgcn_sched_barrier(0); }
}
HD void fwd_p3(cf* x, int t, cf* lds) {
#pragma unroll
  for (int j = 0; j < 16; ++j) x[j] = lds[17 * t + j];
  dft16_nt<false>(x);
}
HD void inv_p3(cf* x, int t, const FftTw& tw, cf* lds) {
  dft16_tn<true>(x);
  __builtin_amdgcn_sched_barrier(0);
  cf pw = cf{1.f, 0.f};
#pragma unroll
  for (int n = 0; n < 16; ++n) { lds[17 * t + n] = cmulc(x[n], pw); pw = cmul(pw, tw.c2); __builtin_amdgcn_sched_barrier(0); }
}
HD void inv_p2(cf* x, int t, const FftTw& tw, cf* lds) {
  int k1 = t >> 4, n2b = t & 15;
#pragma unroll
  for (int j = 0; j < 16; ++j) x[j] = lds[(272 * k1 + n2b) + 17 * j];
  dft16_nt<true>(x);
  __builtin_amdgcn_sched_barrier(0);
  cf pw = tw.c4;
#pragma unroll
  for (int k = 0; k < 16; ++k) { lds[(272 * k1 + n2b) + 17 * k] = cmulc(x[KOF(k)], pw); pw = cmul(pw, tw.c5); if ((k & 3) == 3) __builtin_amdgcn_sched_barrier(0); }
}
HD void inv_p1(cf* x, int t, cf* lds) {
#pragma unroll
  for (int r = 0; r < 16; ++r) x[r] = lds[(t + (t >> 4)) + 272 * KOF(r)];
  dft16_tn<true>(x);
}
HD void fft_fwd(cf* x, int t, const FftTw& tw0, cf* lds) {
  FftTw tw; tw.c1 = cf{launderf(tw0.c1.x), launderf(tw0.c1.y)}; tw.c2 = cf{launderf(tw0.c2.x), launderf(tw0.c2.y)}; tw.c4 = tw0.c4; tw.c5 = tw0.c5;
  fwd_p1(x, t, tw, lds); __syncthreads();
  fwd_p2(x, t, tw, lds); __syncthreads();
  fwd_p3(x, t, lds); __syncthreads();
}
HD void fft_inv(cf* x, int t, const FftTw& tw0, cf* lds) {
  FftTw tw; tw.c2 = cf{launderf(tw0.c2.x), launderf(tw0.c2.y)}; tw.c4 = cf{launderf(tw0.c4.x), launderf(tw0.c4.y)}; tw.c5 = cf{launderf(tw0.c5.x), launderf(tw0.c5.y)}; tw.c1 = tw0.c1;
  inv_p3(x, t, tw, lds); __syncthreads();
  inv_p2(x, t, tw, lds); __syncthreads();
  inv_p1(x, t, lds); __syncthreads();
}
HD cf cispi(float a) { float s, c; sincospif(a, &s, &c); return cf{c, s}; }

__device__ __forceinline__ void gemm_tile(const bf16* __restrict__ A, int lda, const bf16* __restrict__ Bt, int ldb, int K, char* smem,
                                          f32x4 (&acc)[4][4]) {
  const int tid = launder((int)threadIdx.x), lane = tid & 63, w = tid >> 6, wr = w >> 1, wc = w & 1, l15 = lane & 15, quad = lane >> 4;
#pragma unroll
  for (int m = 0; m < 4; ++m)
#pragma unroll
    for (int n = 0; n < 4; ++n) acc[m][n] = f32x4{0.f, 0.f, 0.f, 0.f};
  uint4 ra[4], rb[4];
  const int nk = K >> 6;
  const bf16* ga[4]; const bf16* gb[4]; int so[4];
#pragma unroll
  for (int q = 0; q < 4; ++q) {
    int id = tid + 256 * q, r = id >> 3, ch = id & 7;
    ga[q] = A + (size_t)r * lda + ch * 8;
    gb[q] = Bt + (size_t)r * ldb + ch * 8;
    so[q] = r * 128 + ((ch ^ (r & 7)) << 4);
  }
#pragma unroll
  for (int q = 0; q < 4; ++q) { ra[q] = *(const uint4*)(ga[q]); rb[q] = *(const uint4*)(gb[q]); }
#pragma unroll
  for (int q = 0; q < 4; ++q) { *(uint4*)(smem + so[q]) = ra[q]; *(uint4*)(smem + 16384 + so[q]) = rb[q]; }
  __syncthreads();
  for (int kt = 0; kt < nk; ++kt) {
    char* cur = smem + (kt & 1) * 32768;
    char* nxt = smem + ((kt + 1) & 1) * 32768;
    if (kt + 1 < nk) {
#pragma unroll
      for (int q = 0; q < 4; ++q) { ra[q] = *(const uint4*)(ga[q] + (kt + 1) * 64); rb[q] = *(const uint4*)(gb[q] + (kt + 1) * 64); }
    }
#pragma unroll
    for (int kk = 0; kk < 2; ++kk) {
      bf16x8 af[4], bfr[4];
#pragma unroll
      for (int m = 0; m < 4; ++m) {
        int r = wr * 64 + m * 16 + l15;
        af[m] = *(const bf16x8*)(cur + r * 128 + (((kk * 4 + quad) ^ (r & 7)) << 4));
      }
#pragma unroll
      for (int n = 0; n < 4; ++n) {
        int r = wc * 64 + n * 16 + l15;
        bfr[n] = *(const bf16x8*)(cur + 16384 + r * 128 + (((kk * 4 + quad) ^ (r & 7)) << 4));
      }
#pragma unroll
      for (int m = 0; m < 4; ++m)
#pragma unroll
        for (int n = 0; n < 4; ++n) acc[m][n] = __builtin_amdgcn_mfma_f32_16x16x32_bf16(af[m], bfr[n], acc[m][n], 0, 0, 0);
    }
    if (kt + 1 < nk) {
#pragma unroll
      for (int q = 0; q < 4; ++q) { *(uint4*)(nxt + so[q]) = ra[q]; *(uint4*)(nxt + 16384 + so[q]) = rb[q]; }
    }
    __syncthreads();
  }
}

__device__ void transpose_tile(const float* __restrict__ src, int ldsrc, int k0, int srccol0, bf16* __restrict__ dst, int lddst, int dstrow0,
                               const float* __restrict__ gk, bool zero, char* smem) {
  float* tl = (float*)smem;
  const int tid = launder((int)threadIdx.x);
#pragma unroll 4
  for (int i = 0; i < 16; ++i) {
    int kk = (tid >> 6) + 4 * i, nn = tid & 63;
    float v = zero ? 0.f : src[(size_t)(k0 + kk) * ldsrc + srccol0 + nn];
    if (gk) v *= gk[k0 + kk];
    tl[kk * 65 + nn] = v;
  }
  __syncthreads();
#pragma unroll
  for (int i = 0; i < 2; ++i) {
    int id = tid + 256 * i, nn = id >> 3, kc = id & 7;
    uint4 o;
    o.x = pack2(tl[(kc * 8 + 0) * 65 + nn], tl[(kc * 8 + 1) * 65 + nn]);
    o.y = pack2(tl[(kc * 8 + 2) * 65 + nn], tl[(kc * 8 + 3) * 65 + nn]);
    o.z = pack2(tl[(kc * 8 + 4) * 65 + nn], tl[(kc * 8 + 5) * 65 + nn]);
    o.w = pack2(tl[(kc * 8 + 6) * 65 + nn], tl[(kc * 8 + 7) * 65 + nn]);
    *(uint4*)(dst + (size_t)(dstrow0 + nn) * lddst + k0 + kc * 8) = o;
  }
  __syncthreads();
}
__device__ void win_transpose_task(const Params& P, int l, int task, char* smem) {
  int nt = task >> 5, kt = task & 31;
  int n0 = nt * 64;
  int srccol; bool zero = false;
  if (n0 < 1856) srccol = n0;
  else if (n0 < 2880) srccol = 4928 + (n0 - 1856);
  else if (n0 < 2944) { srccol = 0; zero = true; }
  else srccol = 1856 + (n0 - 2944);
  transpose_tile(P.w_in + (size_t)l * DM * NIN, NIN, kt * 64, srccol, P.wT_in, DM, n0, nullptr, zero, smem);
}
__device__ void modulation_task(const Params& P, int task, char* smem) {
  float* s = (float*)smem;
  float* red = s + 5 * 2048;
  const int tid = launder((int)threadIdx.x);
  int l = task / 96, cgp = task % 96;
  for (int i = tid; i < 5 * 2048; i += NT) {
    int v = i >> 11, k = i & 2047;
    float cv = (v < 4) ? P.c[v * 2048 + k] : P.c_ctx[k];
    s[i] = cv / (1.f + expf(-cv));
  }
  __syncthreads();
  int kg = tid >> 6, cj = tid & 63, col = cgp * 64 + cj;
  float acc[5] = {0.f, 0.f, 0.f, 0.f, 0.f};
  const float* wp = P.ada_w + ((size_t)l * 2048 + kg * 512) * 6144 + col;
  const float* sp = s + kg * 512;
#pragma unroll 8
  for (int k = 0; k < 512; ++k) {
    float wv = wp[(size_t)k * 6144];
#pragma unroll
    for (int v = 0; v < 5; ++v) acc[v] += sp[v * 2048 + k] * wv;
  }
#pragma unroll
  for (int v = 0; v < 5; ++v) red[(kg * 5 + v) * 64 + cj] = acc[v];
  __syncthreads();
  for (int i = tid; i < 320; i += NT) {
    int v = i >> 6, c2 = i & 63;
    float a = red[(0 * 5 + v) * 64 + c2] + red[(1 * 5 + v) * 64 + c2] + red[(2 * 5 + v) * 64 + c2] + red[(3 * 5 + v) * 64 + c2];
    int cc = cgp * 64 + c2;
    P.mod[(size_t)(l * 5 + v) * 6144 + cc] = a + P.ada_b[l * 6144 + cc];
  }
  __syncthreads();
}
__device__ void h2_task(const Params& P, int task, char* smem) {
  float* zf = (float*)smem;
  float* h1 = zf + 4 * 36;
  const int tid = launder((int)threadIdx.x), pos = tid >> 6, j = tid & 63;
  int which, n0;
  if (task < 1024) { which = 0; n0 = task * 4; }
  else if (task < 2048) { which = 1; n0 = (task - 1024) * 4; }
  else { which = 2; n0 = (task - 2048) * 4; }
  const int Lc = (which == 2) ? 256 : 4096;
  const int l = (which == 1) ? 1 : 0;
  const int n = n0 + pos;
  if (j < 33) {
    float v;
    if (j == 0) v = (float)n / (float)(Lc - 1);
    else {
      int k = (j - 1) & 15;
      float f = 1e-4f + (float)k * ((15.f - 1e-4f) / 15.f);
      float wpos = (6.283185307179586f * (float)n) / (float)Lc;
      float a = f * wpos;
      v = (j <= 16) ? cosf(a) : -sinf(a);
    }
    zf[pos * 36 + j] = v;
  }
  __syncthreads();
  float fr = P.filt_freq[l * 64 + j];
  float a = P.filt_b1[l * 64 + j];
#pragma unroll
  for (int i = 0; i < 33; ++i) a += zf[pos * 36 + i] * P.filt_w1[(l * 33 + i) * 64 + j];
  h1[pos * 64 + j] = sinf(fr * a);
  __syncthreads();
  float a2 = P.filt_b2[l * 64 + j];
#pragma unroll 8
  for (int i = 0; i < 64; ++i) a2 += h1[pos * 64 + i] * P.filt_w2[(l * 64 + i) * 64 + j];
  float hv = sinf(fr * a2);
  if (which == 2) P.h2cT[j * 256 + n] = hv;
  else P.h2T[((size_t)l * 64 + j) * 4096 + n] = hv;
  __syncthreads();
}
__device__ void rope_table_task(const Params& P) {
  for (int i = launder((int)threadIdx.x); i < 64 * 16; i += NT) {
    int pos = i >> 4, f = i & 15;
    float inv = powf(10000.f, -(float)f / 16.f);
    float ang = (float)pos * inv;
    P.rope[2 * i] = cosf(ang);
    P.rope[2 * i + 1] = sinf(ang);
  }
}

__device__ __forceinline__ void prenorm_store(const Params& P, const float4* v, int row, int l, int mv, int lane) {
  float ss = 0.f;
#pragma unroll
  for (int i = 0; i < 8; ++i) ss += v[i].x * v[i].x + v[i].y * v[i].y + v[i].z * v[i].z + v[i].w * v[i].w;
  ss = wave_sum(ss);
  float r = rsqrtf(ss * (1.f / 2048.f) + EPSN);
  const float* md = P.mod + (size_t)(l * 5 + mv) * 6144;
#pragma unroll
  for (int i = 0; i < 8; ++i) {
    int idx = (i * 64 + lane) * 4;
    float4 g = *(const float4*)(P.pre_g + l * 2048 + idx);
    float4 sh = *(const float4*)(md + idx);
    float4 sc = *(const float4*)(md + 2048 + idx);
    float o0 = v[i].x * r * g.x * (1.f + sc.x) + sh.x;
    float o1 = v[i].y * r * g.y * (1.f + sc.y) + sh.y;
    float o2 = v[i].z * r * g.z * (1.f + sc.z) + sh.z;
    float o3 = v[i].w * r * g.w * (1.f + sc.w) + sh.w;
    uint2 o; o.x = pack2(o0, o1); o.y = pack2(o2, o3);
    *(uint2*)(P.xh + (size_t)row * 2048 + idx) = o;
  }
}
__device__ void phase_prenorm0(const Params& P) {
  const int lane = launder((int)threadIdx.x) & 63, wv = launder((int)threadIdx.x) >> 6;
  for (int row = blockIdx.x * 4 + wv; row < TT; row += gridDim.x * 4) {
    const float* src = (row < TX) ? (P.x + (size_t)row * 2048) : (P.ctx + (size_t)(row - TX) * 2048);
    int mv = (row < TX) ? (row >> 12) : 4;
    float4 v[8];
#pragma unroll
    for (int i = 0; i < 8; ++i) v[i] = *(const float4*)(src + (i * 64 + lane) * 4);
    prenorm_store(P, v, row, 0, mv, lane);
  }
}
__device__ void phase_post(const Params& P, int l) {
  const int lane = launder((int)threadIdx.x) & 63, wv = launder((int)threadIdx.x) >> 6;
  const int nrows = (l == 0) ? TT : TX;
  for (int row = blockIdx.x * 4 + wv; row < nrows; row += gridDim.x * 4) {
    const bool isx = row < TX;
    int mv = isx ? (row >> 12) : 4;
    const float* zr = P.z + (size_t)row * 2048;
    const float* xo = (l == 0) ? (isx ? P.x + (size_t)row * 2048 : P.ctx + (size_t)(row - TX) * 2048) : (P.out + (size_t)row * 2048);
    float* xn = isx ? (P.out + (size_t)row * 2048) : (P.ctx1 + (size_t)(row - TX) * 2048);
    float4 zv[8];
    float ss = 0.f;
#pragma unroll
    for (int i = 0; i < 8; ++i) {
      zv[i] = *(const float4*)(zr + (i * 64 + lane) * 4);
      ss += zv[i].x * zv[i].x + zv[i].y * zv[i].y + zv[i].z * zv[i].z + zv[i].w * zv[i].w;
    }
    ss = wave_sum(ss);
    float r = rsqrtf(ss * (1.f / 2048.f) + EPSN);
    const float* gt = P.mod + (size_t)(l * 5 + mv) * 6144 + 4096;
#pragma unroll
    for (int i = 0; i < 8; ++i) {
      int idx = (i * 64 + lane) * 4;
      float4 xv = *(const float4*)(xo + idx);
      float4 g = *(const float4*)(gt + idx);
      float4 pg = *(const float4*)(P.post_g + l * 2048 + idx);
      zv[i].x = xv.x + g.x * zv[i].x * r * pg.x;
      zv[i].y = xv.y + g.y * zv[i].y * r * pg.y;
      zv[i].z = xv.z + g.z * zv[i].z * r * pg.z;
      zv[i].w = xv.w + g.w * zv[i].w * r * pg.w;
      *(float4*)(xn + idx) = zv[i];
    }
    if (l == 0) prenorm_store(P, zv, row, 1, mv, lane);
  }
  if (l == 0) {
  }
}

__device__ void gemm_in_task(const Params& P, int l, int mt, int nt, char* smem) {
  f32x4 acc[4][4];
  const int row0 = mt * 128, col0 = nt * 128;
  gemm_tile(P.xh + (size_t)row0 * DM, DM, P.wT_in + (size_t)col0 * DM, DM, DM, smem, acc);
  const int tid = launder((int)threadIdx.x), lane = tid & 63, w = tid >> 6, wr = w >> 1, wc = w & 1, l15 = lane & 15, quad = lane >> 4;
  const int rowbase = row0 + wr * 64, colbase = col0 + wc * 64;
  const bool isx = row0 < TX;
  if (colbase < NPA) {
    if (colbase == 768) {
#pragma unroll
      for (int m = 0; m < 4; ++m)
#pragma unroll
        for (int j = 0; j < 4; ++j) {
          int row = rowbase + m * 16 + quad * 4 + j;
          float v0 = acc[m][0][j], v1 = acc[m][1][j], v2 = acc[m][2][j], v3 = acc[m][3][j];
          int b, kk;
          if (isx) {
            int t = row & 4095; b = row >> 12; kk = 256 + t;
            float2 cs0 = *(const float2*)(P.rope + 2 * ((t >> 6) * 16 + l15));
            float2 cs1 = *(const float2*)(P.rope + 2 * ((t & 63) * 16 + l15));
            float a0 = v0 * cs0.x - v1 * cs0.y, a1 = v1 * cs0.x + v0 * cs0.y;
            float a2 = v2 * cs1.x - v3 * cs1.y, a3 = v3 * cs1.x + v2 * cs1.y;
            v0 = a0; v1 = a1; v2 = a2; v3 = a3;
          } else { int rc = row - TX; b = rc >> 8; kk = rc & 255; }
          bf16* dst = P.kr + ((size_t)b * LK + kk) * 64 + l15;
          dst[0] = f2bf(v0); dst[16] = f2bf(v1); dst[32] = f2bf(v2); dst[48] = f2bf(v3);
        }
    } else {
#pragma unroll
      for (int m = 0; m < 4; ++m)
#pragma unroll
        for (int n = 0; n < 4; ++n)
#pragma unroll
          for (int j = 0; j < 4; ++j) {
            int row = rowbase + m * 16 + quad * 4 + j, col = colbase + n * 16 + l15;
            P.pa[(size_t)row * NPA + col] = f2bf(acc[m][n][j]);
          }
    }
  } else {
    const int hc0 = colbase - NPA;
    if (isx) {
      const int b = row0 >> 12, t0 = (rowbase & 4095);
#pragma unroll
      for (int m = 0; m < 4; ++m)
#pragma unroll
        for (int n = 0; n < 4; ++n) {
          int hc = hc0 + n * 16 + l15, t = t0 + m * 16 + quad * 4;
          uint2 o; o.x = pack2(acc[m][n][0], acc[m][n][1]); o.y = pack2(acc[m][n][2], acc[m][n][3]);
          *(uint2*)(P.pT + ((size_t)b * NHYC + hc) * 4096 + t) = o;
        }
    } else {
#pragma unroll
      for (int m = 0; m < 4; ++m)
#pragma unroll
        for (int n = 0; n < 4; ++n)
#pragma unroll
          for (int j = 0; j < 4; ++j) {
            int row = rowbase + m * 16 + quad * 4 + j - TX, hc = hc0 + n * 16 + l15;
            P.pchy[(size_t)row * NHYC + hc] = f2bf(acc[m][n][j]);
          }
    }
  }
}
__device__ void phase_gemm_in(const Params& P, int l, char* smem) {
  const int nx = 128 * 47;
  const int nctx = 8 * ((l == 0) ? 47 : 23);
  for (int id = blockIdx.x; id < nx + nctx; id += gridDim.x) {
    int mt, nt;
    if (id < nx) { mt = (id / 376) * 8 + (id & 7); nt = (id % 376) >> 3; }
    else { int i2 = id - nx; mt = 128 + (i2 & 7); nt = i2 >> 3; }
    gemm_in_task(P, l, mt, nt, smem);
  }
}

__device__ void q_gemm_task(const Params& P, int l, int mt, int nt, char* smem) {
  float* rs = (float*)(smem + 65536);
  const int tid = launder((int)threadIdx.x), lane = tid & 63, w = tid >> 6, wr = w >> 1, wc = w & 1, l15 = lane & 15, quad = lane >> 4;
  const int row0 = mt * 128, col0 = nt * 128;
  for (int rr = 0; rr < 32; ++rr) {
    int r = w * 32 + rr;
    uint4 v = *(const uint4*)(P.pa + (size_t)(row0 + r) * NPA + lane * 8);
    float ss = 0.f;
    unsigned uu[4] = {v.x, v.y, v.z, v.w};
#pragma unroll
    for (int e = 0; e < 4; ++e) { float a = __uint_as_float(uu[e] << 16), b = __uint_as_float(uu[e] & 0xffff0000u); ss += a * a + b * b; }
    ss = wave_sum(ss);
    if (lane == 0) rs[r] = rsqrtf(ss * (1.f / 512.f) + EPSN) * QSCALE;
  }
  __syncthreads();
  f32x4 acc[4][4];
  gemm_tile(P.pa + (size_t)row0 * NPA, NPA, P.wT_uq + (size_t)l * QW * 512 + (size_t)col0 * 512, 512, 512, smem, acc);
  const int rowbase = row0 + wr * 64, colbase = col0 + wc * 64;
  const bool isx = row0 < TX;
  const bool ropet = isx && (((colbase >> 6) % 3) == 2);
#pragma unroll
  for (int m = 0; m < 4; ++m)
#pragma unroll
    for (int j = 0; j < 4; ++j) {
      int row = rowbase + m * 16 + quad * 4 + j;
      float sc = rs[row - row0];
      float v0 = acc[m][0][j] * sc, v1 = acc[m][1][j] * sc, v2 = acc[m][2][j] * sc, v3 = acc[m][3][j] * sc;
      if (ropet) {
        int t = row & 4095;
        float2 cs0 = *(const float2*)(P.rope + 2 * ((t >> 6) * 16 + l15));
        float2 cs1 = *(const float2*)(P.rope + 2 * ((t & 63) * 16 + l15));
        float a0 = v0 * cs0.x - v1 * cs0.y, a1 = v1 * cs0.x + v0 * cs0.y;
        float a2 = v2 * cs1.x - v3 * cs1.y, a3 = v3 * cs1.x + v2 * cs1.y;
        v0 = a0; v1 = a1; v2 = a2; v3 = a3;
      }
      bf16* dst = P.qbuf + (size_t)row * QW + colbase + l15;
      dst[0] = f2bf(v0); dst[16] = f2bf(v1); dst[32] = f2bf(v2); dst[48] = f2bf(v3);
    }
  __syncthreads();
}
__device__ void kv_gemm_task(const Params& P, int l, int mt, int nt, char* smem) {
  float* rs = (float*)(smem + 65536);
  const int tid = launder((int)threadIdx.x), lane = tid & 63, w = tid >> 6, wr = w >> 1, wc = w & 1, l15 = lane & 15, quad = lane >> 4;
  const int row0 = mt * 128, col0 = nt * 128;
  for (int rr = 0; rr < 32; ++rr) {
    int r = w * 32 + rr;
    uint2 v = *(const uint2*)(P.pa + (size_t)(row0 + r) * NPA + 512 + lane * 4);
    float a0 = __uint_as_float(v.x << 16), a1 = __uint_as_float(v.x & 0xffff0000u), a2 = __uint_as_float(v.y << 16), a3 = __uint_as_float(v.y & 0xffff0000u);
    float ss = wave_sum(a0 * a0 + a1 * a1 + a2 * a2 + a3 * a3);
    if (lane == 0) rs[r] = rsqrtf(ss * (1.f / 256.f) + EPSN);
  }
  __syncthreads();
  f32x4 acc[4][4];
  gemm_tile(P.pa + (size_t)row0 * NPA + 512, NPA, P.wT_ukv + (size_t)l * 2048 * 256 + (size_t)col0 * 256, 256, 256, smem, acc);
  const int rowbase = row0 + wr * 64;
  const int h = nt >> 1;
  int b, kk0;
  if (row0 < TX) { b = row0 >> 12; kk0 = 256 + (rowbase & 4095); }
  else { int rc = rowbase - TX; b = rc >> 8; kk0 = rc & 255; }
  if ((nt & 1) == 0) {
#pragma unroll
    for (int m = 0; m < 4; ++m)
#pragma unroll
      for (int j = 0; j < 4; ++j) {
        int rl = m * 16 + quad * 4 + j;
        float sc = rs[wr * 64 + rl];
        bf16* dst = P.Kn + (((size_t)b * 8 + h) * LK + kk0 + rl) * 128 + wc * 64 + l15;
#pragma unroll
        for (int n = 0; n < 4; ++n) dst[n * 16] = f2bf(acc[m][n][j] * sc);
      }
  } else {
#pragma unroll
    for (int m = 0; m < 4; ++m) {
      int rl = m * 16 + quad * 4;
      float s0 = rs[wr * 64 + rl], s1 = rs[wr * 64 + rl + 1], s2 = rs[wr * 64 + rl + 2], s3 = rs[wr * 64 + rl + 3];
#pragma unroll
      for (int n = 0; n < 4; ++n) {
        int d = wc * 64 + n * 16 + l15;
        uint2 o; o.x = pack2(acc[m][n][0] * s0, acc[m][n][1] * s1); o.y = pack2(acc[m][n][2] * s2, acc[m][n][3] * s3);
        *(uint2*)(P.vT + (((size_t)b * 8 + h) * 128 + d) * LK + kk0 + rl) = o;
      }
    }
  }
  __syncthreads();
}

__device__ __forceinline__ float conv3(const bf16* __restrict__ rowp, int n, float w0, float w1, float w2, float bb) {
  float a = bb + w1 * bf2f(rowp[n]);
  if (n > 0) a += w0 * bf2f(rowp[n - 1]);
  if (n < 4095) a += w2 * bf2f(rowp[n + 1]);
  return a;
}
__device__ void hyena_x_task(const Params& P, int l, int c, char* smem) {
  cf* lds = (cf*)smem;
  cf* est = (cf*)(smem + 34816);
  float* hbx = (float*)(smem + 34816);
  float* w3s = (float*)(smem + 34816 + 32768);
  const int t = launder((int)threadIdx.x);
  FftTw tw;
  tw.c1 = cispi(-(float)t / 2048.f);
  tw.c2 = cispi(-(float)(t & 15) / 128.f);
  tw.c4 = cispi(-(float)((t & 15) * (t >> 4)) / 2048.f);
  tw.c5 = cispi(-(float)(t >> 4) / 128.f);
  const cf c8 = cispi(-(float)t / 4096.f);
  const cf w32 = cf{0.98078528040323043f, -0.19509032201612825f};
  if (t < 128) w3s[t] = P.filt_w3[((size_t)l * 64 + (t & 63)) * 2048 + (t >> 6) * 1024 + c];
  __syncthreads();
  cf* kfe = (cf*)P.kfg + (size_t)blockIdx.x * 8192;
  cf* kfo = kfe + 4096;
  {
    cf ke[16];
    float af[16], ab[16];
#pragma unroll
    for (int j = 0; j < 16; ++j) { af[j] = 0.f; ab[j] = 0.f; }
    const float* h2p = P.h2T + (size_t)l * 64 * 4096;
#pragma unroll 1
    for (int i = 0; i < 64; ++i) {
      float wf = w3s[i], wb = w3s[64 + i];
#pragma unroll
      for (int j = 0; j < 16; ++j) { float hv = h2p[i * 4096 + j * 256 + t]; af[j] += hv * wf; ab[j] += hv * wb; }
    }
    const float d0 = -15.350567286626973f, d1 = -3.0701134573253946f;
    const float adel = fabsf(d0 + (float)c * ((d1 - d0) / 1023.f));
#pragma unroll
    for (int j = 0; j < 16; ++j) {
      int n = 256 * j + t;
      float dec = expf(-((float)n * (1.f / 4095.f)) * adel);
      af[j] *= dec; ab[j] *= dec;
      hbx[n] = ab[j];
    }
    __syncthreads();
#pragma unroll
    for (int j = 0; j < 16; ++j) {
      int n = 256 * j + t;
      float k1 = (n == 0) ? 0.f : hbx[4096 - n];
      ke[j] = cf{af[j] + k1, 0.f};
      af[j] = af[j] - k1;
    }
    __syncthreads();
    fft_fwd(ke, t, tw, lds);
    { const int tl = launder(t); _Pragma("unroll") for (int r = 0; r < 16; ++r) kfe[r * 256 + tl] = ke[r]; }
    cf wn = cf{launderf(c8.x), launderf(c8.y)};
#pragma unroll
    for (int j = 0; j < 16; ++j) { ke[j] = cf{af[j] * wn.x, af[j] * wn.y}; wn = cmul(wn, w32); }
    fft_fwd(ke, t, tw, lds);
    { const int tl = launder(t); _Pragma("unroll") for (int r = 0; r < 16; ++r) kfo[r * 256 + tl] = ke[r]; }
  }
  const float cw10 = P.conv_w[(l * 3 + 0) * 3072 + 1024 + c], cw11 = P.conv_w[(l * 3 + 1) * 3072 + 1024 + c], cw12 = P.conv_w[(l * 3 + 2) * 3072 + 1024 + c];
  const float cwv0 = P.conv_w[(l * 3 + 0) * 3072 + 2048 + c], cwv1 = P.conv_w[(l * 3 + 1) * 3072 + 2048 + c], cwv2 = P.conv_w[(l * 3 + 2) * 3072 + 2048 + c];
  const float cw00 = P.conv_w[(l * 3 + 0) * 3072 + c], cw01 = P.conv_w[(l * 3 + 1) * 3072 + c], cw02 = P.conv_w[(l * 3 + 2) * 3072 + c];
  const float cb0 = P.conv_b[l * 3072 + c], cb1 = P.conv_b[l * 3072 + 1024 + c], cbv = P.conv_b[l * 3072 + 2048 + c];
  const float Dc = P.hy_D[l * 1024 + c];
  for (int pr = 0; pr < 2; ++pr) {
    const int b0 = 2 * pr, b1 = 2 * pr + 1;
    const bf16* p1a = P.pT + ((size_t)b0 * NHYC + 1024 + c) * 4096;
    const bf16* pva = P.pT + ((size_t)b0 * NHYC + 2048 + c) * 4096;
    const bf16* p1b = P.pT + ((size_t)b1 * NHYC + 1024 + c) * 4096;
    const bf16* pvb = P.pT + ((size_t)b1 * NHYC + 2048 + c) * 4096;
    cf x[16];
#pragma unroll 1
    for (int j = 0; j < 16; ++j) {
      int n = 256 * j + t;
      float ua = conv3(p1a, n, cw10, cw11, cw12, cb1) * conv3(pva, n, cwv0, cwv1, cwv2, cbv);
      float ub = conv3(p1b, n, cw10, cw11, cw12, cb1) * conv3(pvb, n, cwv0, cwv1, cwv2, cbv);
      lds[(t + (t >> 4)) + 272 * j] = cf{ua, ub};
    }
#pragma unroll
    for (int j = 0; j < 16; ++j) x[j] = lds[(t + (t >> 4)) + 272 * j];
    fft_fwd(x, t, tw, lds);
    { const int tl = launder(t); _Pragma("unroll") for (int r = 0; r < 16; ++r) x[r] = cmul(x[r], kfe[r * 256 + tl]); }
    fft_inv(x, t, tw, lds);
#pragma unroll
    for (int j = 0; j < 16; ++j) est[256 * j + t] = x[j];
    {
      cf wn = cf{launderf(c8.x), launderf(c8.y)};
#pragma unroll 1
      for (int j = 0; j < 16; ++j) {
        int n = 256 * j + t;
        float ua = conv3(p1a, n, cw10, cw11, cw12, cb1) * conv3(pva, n, cwv0, cwv1, cwv2, cbv);
        float ub = conv3(p1b, n, cw10, cw11, cw12, cb1) * conv3(pvb, n, cwv0, cwv1, cwv2, cbv);
        lds[(t + (t >> 4)) + 272 * j] = cmul(cf{ua, ub}, wn);
        wn = cmul(wn, w32);
      }
    }
#pragma unroll
    for (int j = 0; j < 16; ++j) x[j] = lds[(t + (t >> 4)) + 272 * j];
    fft_fwd(x, t, tw, lds);
    { const int tl = launder(t); _Pragma("unroll") for (int r = 0; r < 16; ++r) x[r] = cmul(x[r], kfo[r * 256 + tl]); }
    fft_inv(x, t, tw, lds);
    {
      cf wn = cf{launderf(c8.x), launderf(c8.y)};
#pragma unroll
      for (int j = 0; j < 16; ++j) {
        int n = 256 * j + t;
        cf o = cmulc(x[j], wn);
        cf e = est[n];
        est[n] = cf{(e.x + o.x) * (1.f / 8192.f), (e.y + o.y) * (1.f / 8192.f)};
        wn = cmul(wn, w32);
      }
    }
    const bf16* p0a = P.pT + ((size_t)b0 * NHYC + c) * 4096;
    const bf16* p0b = P.pT + ((size_t)b1 * NHYC + c) * 4096;
    bf16* oa = P.yhT + ((size_t)b0 * 1024 + c) * 4096;
    bf16* ob = P.yhT + ((size_t)b1 * 1024 + c) * 4096;
#pragma unroll 1
    for (int j = 0; j < 16; ++j) {
      int n = 256 * j + t;
      cf y = est[n];
      float ua = conv3(p1a, n, cw10, cw11, cw12, cb1) * conv3(pva, n, cwv0, cwv1, cwv2, cbv);
      float ub = conv3(p1b, n, cw10, cw11, cw12, cb1) * conv3(pvb, n, cwv0, cwv1, cwv2, cbv);
      float xa = conv3(p0a, n, cw00, cw01, cw02, cb0), xb = conv3(p0b, n, cw00, cw01, cw02, cb0);
      oa[n] = f2bf(xa * (y.x + Dc * ua));
      ob[n] = f2bf(xb * (y.y + Dc * ub));
    }
  }
  __syncthreads();
}
__device__ void hyena_ctx_task(const Params& P, int c, char* smem) {
  float* hf = (float*)smem;
  float* hb = hf + 256;
  float* us = hb + 256;
  const int t = launder((int)threadIdx.x);
  const int l = 0;
  float af = 0.f, ab = 0.f;
  for (int i = 0; i < 64; ++i) {
    float hv = P.h2cT[i * 256 + t];
    af += hv * P.filt_w3[((size_t)l * 64 + i) * 2048 + c];
    ab += hv * P.filt_w3[((size_t)l * 64 + i) * 2048 + 1024 + c];
  }
  const float d0 = -15.350567286626973f, d1 = -3.0701134573253946f;
  const float adel = fabsf(d0 + (float)c * ((d1 - d0) / 1023.f));
  float dec = expf(-((float)t / 255.f) * adel);
  hf[t] = af * dec; hb[t] = ab * dec;
  float x0c[4], uu[4];
#pragma unroll
  for (int b = 0; b < 4; ++b) {
    const bf16* base = P.pchy + (size_t)(b * 256) * NHYC;
    float cv[3];
#pragma unroll
    for (int g = 0; g < 3; ++g) {
      int col = g * 1024 + c;
      float a = P.conv_b[l * 3072 + col] + P.conv_w[(l * 3 + 1) * 3072 + col] * bf2f(base[(size_t)t * NHYC + col]);
      if (t > 0) a += P.conv_w[(l * 3 + 0) * 3072 + col] * bf2f(base[(size_t)(t - 1) * NHYC + col]);
      if (t < 255) a += P.conv_w[(l * 3 + 2) * 3072 + col] * bf2f(base[(size_t)(t + 1) * NHYC + col]);
      cv[g] = a;
    }
    x0c[b] = cv[0]; uu[b] = cv[1] * cv[2];
    us[b * 256 + t] = uu[b];
  }
  __syncthreads();
  float acc[4] = {0.f, 0.f, 0.f, 0.f};
  for (int s = 0; s < 256; ++s) {
    float k = (s <= t) ? hf[t - s] : hb[s - t];
#pragma unroll
    for (int b = 0; b < 4; ++b) acc[b] += k * us[b * 256 + s];
  }
  const float Dc = P.hy_D[l * 1024 + c];
#pragma unroll
  for (int b = 0; b < 4; ++b) {
    int row = TX + b * 256 + t;
    P.xh[(size_t)row * 2048 + 1024 + c] = f2bf(x0c[b] * (acc[b] + Dc * uu[b]));
  }
  __syncthreads();
}
__device__ void phase_d(const Params& P, int l, char* smem) {
  const int nhx = 1024, nhc = (l == 0) ? 1024 : 0;
  const int nqm = (l == 0) ? 136 : 128;
  const int nq = nqm * 12, nkv = 136 * 16;
  const int total = nhx + nhc + nq + nkv;
  for (int id = blockIdx.x; id < total; id += gridDim.x) {
    int i = id;
#ifndef PDM
#define PDM 15
#endif
    if (i < nhx) { if (PDM & 1) hyena_x_task(P, l, i, smem); continue; }
    i -= nhx;
    if (i < nhc) { if (PDM & 2) hyena_ctx_task(P, i, smem); continue; }
    i -= nhc;
    if (i < nq) { if (PDM & 4) q_gemm_task(P, l, i / 12, i % 12, smem); continue; }
    i -= nq;
    if (PDM & 8) kv_gemm_task(P, l, i >> 4, i & 15, smem);
  }
}

__device__ void attn_task(const Params& P, int b, int h, int qrow0, int nkt, char* smem) {
  char* Ks = smem;
  char* Vs = smem + 25600;
  const int tid = launder((int)threadIdx.x), lane = tid & 63, w = tid >> 6, l15 = lane & 15, quad = lane >> 4;
  bf16x8 qf[2][6];
#pragma unroll
  for (int m = 0; m < 2; ++m)
#pragma unroll
    for (int ks = 0; ks < 6; ++ks)
      qf[m][ks] = *(const bf16x8*)(P.qbuf + (size_t)(qrow0 + w * 32 + m * 16 + l15) * QW + h * 192 + ks * 32 + quad * 8);
  const bf16* Kg = P.Kn + ((size_t)b * 8 + h) * LK * 128;
  const bf16* Rg = P.kr + (size_t)b * LK * 64;
  const bf16* Vg = P.vT + ((size_t)b * 8 + h) * 128 * LK;
  uint4 sk[4], sr[2], sv[4];
  auto gload = [&](int kt) {
#pragma unroll
    for (int q = 0; q < 4; ++q) { int id = tid + 256 * q; int key = id >> 4, ch = id & 15; sk[q] = *(const uint4*)(Kg + (size_t)(kt * 64 + key) * 128 + ch * 8); }
#pragma unroll
    for (int q = 0; q < 2; ++q) { int id = tid + 256 * q; int key = id >> 3, ch = id & 7; sr[q] = *(const uint4*)(Rg + (size_t)(kt * 64 + key) * 64 + ch * 8); }
#pragma unroll
    for (int q = 0; q < 4; ++q) { int id = tid + 256 * q; int d = id >> 3, ch = id & 7; sv[q] = *(const uint4*)(Vg + (size_t)d * LK + kt * 64 + ch * 8); }
  };
  auto lstore = [&]() {
#pragma unroll
    for (int q = 0; q < 4; ++q) { int id = tid + 256 * q; int key = id >> 4, ch = id & 15; *(uint4*)(Ks + key * 400 + ch * 16) = sk[q]; }
#pragma unroll
    for (int q = 0; q < 2; ++q) { int id = tid + 256 * q; int key = id >> 3, ch = id & 7; *(uint4*)(Ks + key * 400 + 256 + ch * 16) = sr[q]; }
#pragma unroll
    for (int q = 0; q < 4; ++q) { int id = tid + 256 * q; int d = id >> 3, ch = id & 7; *(uint4*)(Vs + d * 144 + ch * 16) = sv[q]; }
  };
  f32x4 oacc[8][2];
#pragma unroll
  for (int nd = 0; nd < 8; ++nd) { oacc[nd][0] = f32x4{0.f, 0.f, 0.f, 0.f}; oacc[nd][1] = f32x4{0.f, 0.f, 0.f, 0.f}; }
  float mrow[2] = {-1e30f, -1e30f}, lrow[2] = {0.f, 0.f};
  gload(0);
  lstore();
  __syncthreads();
  for (int kt = 0; kt < nkt; ++kt) {
    f32x4 s[4][2];
#pragma unroll
    for (int n = 0; n < 4; ++n) { s[n][0] = f32x4{0.f, 0.f, 0.f, 0.f}; s[n][1] = f32x4{0.f, 0.f, 0.f, 0.f}; }
#pragma unroll
    for (int ks = 0; ks < 6; ++ks) {
#pragma unroll
      for (int n = 0; n < 4; ++n) {
        bf16x8 a = *(const bf16x8*)(Ks + (n * 16 + l15) * 400 + ks * 64 + quad * 16);
        s[n][0] = __builtin_amdgcn_mfma_f32_16x16x32_bf16(a, qf[0][ks], s[n][0], 0, 0, 0);
        s[n][1] = __builtin_amdgcn_mfma_f32_16x16x32_bf16(a, qf[1][ks], s[n][1], 0, 0, 0);
      }
      if (ks & 1) __builtin_amdgcn_sched_barrier(0);
    }
    bf16x8 pb[2][2];
#pragma unroll
    for (int m = 0; m < 2; ++m) {
      float mx = s[0][m][0];
#pragma unroll
      for (int n = 0; n < 4; ++n)
#pragma unroll
        for (int j = 0; j < 4; ++j) mx = fmaxf(mx, s[n][m][j]);
      mx = fmaxf(mx, __shfl_xor(mx, 16));
      mx = fmaxf(mx, __shfl_xor(mx, 32));
      float mn = fmaxf(mrow[m], mx);
      float alpha = exp2f(mrow[m] - mn);
      mrow[m] = mn;
      float ps = 0.f;
#pragma unroll
      for (int n = 0; n < 4; ++n)
#pragma unroll
        for (int j = 0; j < 4; ++j) { float p = exp2f(s[n][m][j] - mn); s[n][m][j] = p; ps += p; }
      lrow[m] = lrow[m] * alpha + ps;
#pragma unroll
      for (int nd = 0; nd < 8; ++nd) { oacc[nd][m][0] *= alpha; oacc[nd][m][1] *= alpha; oacc[nd][m][2] *= alpha; oacc[nd][m][3] *= alpha; }
#pragma unroll
      for (int k2 = 0; k2 < 2; ++k2) {
        uint4 pk;
        pk.x = pack2(s[2 * k2][m][0], s[2 * k2][m][1]); pk.y = pack2(s[2 * k2][m][2], s[2 * k2][m][3]);
        pk.z = pack2(s[2 * k2 + 1][m][0], s[2 * k2 + 1][m][1]); pk.w = pack2(s[2 * k2 + 1][m][2], s[2 * k2 + 1][m][3]);
        pb[m][k2] = *(bf16x8*)&pk;
      }
    }
    __builtin_amdgcn_sched_barrier(0);
#pragma unroll
    for (int nd = 0; nd < 8; ++nd) {
      if ((nd & 1) == 0) __builtin_amdgcn_sched_barrier(0);
#pragma unroll
      for (int k2 = 0; k2 < 2; ++k2) {
        const char* vp = Vs + (nd * 16 + l15) * 144 + k2 * 64 + quad * 8;
        uint2 lo = *(const uint2*)(vp), hi = *(const uint2*)(vp + 32);
        uint4 av = uint4{lo.x, lo.y, hi.x, hi.y};
        bf16x8 a = *(bf16x8*)&av;
        oacc[nd][0] = __builtin_amdgcn_mfma_f32_16x16x32_bf16(a, pb[0][k2], oacc[nd][0], 0, 0, 0);
        oacc[nd][1] = __builtin_amdgcn_mfma_f32_16x16x32_bf16(a, pb[1][k2], oacc[nd][1], 0, 0, 0);
      }
    }
    __syncthreads();
    if (kt + 1 < nkt) { gload(kt + 1); lstore(); }
    __syncthreads();
  }
#pragma unroll
  for (int m = 0; m < 2; ++m) {
    float lt = lrow[m];
    lt += __shfl_xor(lt, 16);
    lt += __shfl_xor(lt, 32);
    float inv = 1.f / lt;
    int row = qrow0 + w * 32 + m * 16 + l15;
#pragma unroll
    for (int nd = 0; nd < 8; ++nd) {
      uint2 o; o.x = pack2(oacc[nd][m][0] * inv, oacc[nd][m][1] * inv); o.y = pack2(oacc[nd][m][2] * inv, oacc[nd][m][3] * inv);
      *(uint2*)(P.xh + (size_t)row * 2048 + h * 128 + nd * 16 + quad * 4) = o;
    }
  }
}
__device__ void phase_attn(const Params& P, int l, char* smem) {
  const int nx = 1024, nc = (l == 0) ? 64 : 0;
  for (int id = blockIdx.x; id < nx + nc; id += gridDim.x) {
    if (id < nx) {
      int j = id >> 3;
      int bh = (id & 7) + 8 * (j >> 5), qt = j & 31;
      int b = bh >> 3, h = bh & 7;
      attn_task(P, b, h, b * 4096 + qt * 128, 68, smem);
    } else {
      int i = id - nx;
      int bh = i >> 1, qt = i & 1;
      int b = bh >> 3, h = bh & 7;
      attn_task(P, b, h, TX + b * 256 + qt * 128, 4, smem);
    }
  }
}

__device__ __forceinline__ void unpack8(uint4 v, float* f) {
  f[0] = __uint_as_float(v.x << 16); f[1] = __uint_as_float(v.x & 0xffff0000u);
  f[2] = __uint_as_float(v.y << 16); f[3] = __uint_as_float(v.y & 0xffff0000u);
  f[4] = __uint_as_float(v.z << 16); f[5] = __uint_as_float(v.z & 0xffff0000u);
  f[6] = __uint_as_float(v.w << 16); f[7] = __uint_as_float(v.w & 0xffff0000u);
}
__device__ __forceinline__ void merge_row(const Params& P, int row, const char* yh_lds  , int lane) {
  bf16* yr = P.xh + (size_t)row * 2048;
  const bf16* gr = P.pa + (size_t)row * NPA;
  float o[2][8], y[2][8];
  float so = 0.f, sy = 0.f;
#pragma unroll
  for (int i = 0; i < 2; ++i) {
    int col = i * 512 + lane * 8;
    unpack8(*(const uint4*)(yr + col), o[i]);
    uint4 yv = yh_lds ? *(const uint4*)(yh_lds + col * 2) : *(const uint4*)(yr + 1024 + col);
    unpack8(yv, y[i]);
#pragma unroll
    for (int e = 0; e < 8; ++e) { so += o[i][e] * o[i][e]; sy += y[i][e] * y[i][e]; }
  }
  so = wave_sum(so); sy = wave_sum(sy);
  float rm = rsqrtf(so * (1.f / 1024.f) + EPSN), rh = rsqrtf(sy * (1.f / 1024.f) + EPSN);
#pragma unroll
  for (int i = 0; i < 2; ++i) {
    int col = i * 512 + lane * 8;
    float gm[8], gh[8];
    unpack8(*(const uint4*)(gr + 832 + col), gm);
    unpack8(*(const uint4*)(gr + 1856 + col), gh);
    uint4 a, b;
    a.x = pack2(o[i][0] * rm * siluf(gm[0]), o[i][1] * rm * siluf(gm[1]));
    a.y = pack2(o[i][2] * rm * siluf(gm[2]), o[i][3] * rm * siluf(gm[3]));
    a.z = pack2(o[i][4] * rm * siluf(gm[4]), o[i][5] * rm * siluf(gm[5]));
    a.w = pack2(o[i][6] * rm * siluf(gm[6]), o[i][7] * rm * siluf(gm[7]));
    b.x = pack2(y[i][0] * rh * siluf(gh[0]), y[i][1] * rh * siluf(gh[1]));
    b.y = pack2(y[i][2] * rh * siluf(gh[2]), y[i][3] * rh * siluf(gh[3]));
    b.z = pack2(y[i][4] * rh * siluf(gh[4]), y[i][5] * rh * siluf(gh[5]));
    b.w = pack2(y[i][6] * rh * siluf(gh[6]), y[i][7] * rh * siluf(gh[7]));
    *(uint4*)(yr + col) = a;
    *(uint4*)(yr + 1024 + col) = b;
  }
}
__device__ void merge_x_task(const Params& P, int task, char* smem) {
  const int tid = launder((int)threadIdx.x), lane = tid & 63, w = tid >> 6;
  const int b = task >> 7, tt = task & 127;
  constexpr int RS = 2064;
#pragma unroll 4
  for (int i = 0; i < 16; ++i) {
    int id = tid + 256 * i, cch = id >> 2, q = id & 3;
    uint4 v = *(const uint4*)(P.yhT + ((size_t)b * 1024 + cch) * 4096 + tt * 32 + q * 8);
    unsigned uu[4] = {v.x, v.y, v.z, v.w};
#pragma unroll
    for (int e = 0; e < 4; ++e) {
      *(bf16*)(smem + (q * 8 + 2 * e) * RS + cch * 2) = (bf16)(uu[e] & 0xffffu);
      *(bf16*)(smem + (q * 8 + 2 * e + 1) * RS + cch * 2) = (bf16)(uu[e] >> 16);
    }
  }
  __syncthreads();
  for (int rr = 0; rr < 8; ++rr) {
    int tk = w * 8 + rr;
    merge_row(P, b * 4096 + tt * 32 + tk, smem + tk * RS, lane);
  }
  __syncthreads();
}
__device__ void phase_merge(const Params& P, int l, char* smem) {
  const int nx = 512, nc = (l == 0) ? 256 : 0, nw = (l == 0) ? 3008 : 0;
  for (int id = blockIdx.x; id < nx + nc + nw; id += gridDim.x) {
    if (id < nx) merge_x_task(P, id, smem);
    else if (id < nx + nc) { int row = TX + (id - nx) * 4 + (launder((int)threadIdx.x) >> 6); merge_row(P, row, nullptr, launder((int)threadIdx.x) & 63); }
    else win_transpose_task(P, 1, id - nx - nc, smem);
  }
}

__device__ void phase_gemm_out(const Params& P, int l, char* smem) {
  const int nm = (l == 0) ? 136 : 128;
  for (int id = blockIdx.x; id < nm * 16; id += gridDim.x) {
    int mt = (id / 128) * 8 + (id & 7), nt = (id & 127) >> 3;
    f32x4 acc[4][4];
    const int row0 = mt * 128, col0 = nt * 128;
    gemm_tile(P.xh + (size_t)row0 * DM, DM, P.wT_out + (size_t)l * DM * DM + (size_t)col0 * DM, DM, DM, smem, acc);
    const int tid = launder((int)threadIdx.x), lane = tid & 63, w = tid >> 6, wr = w >> 1, wc = w & 1, l15 = lane & 15, quad = lane >> 4;
#pragma unroll
    for (int m = 0; m < 4; ++m)
#pragma unroll
      for (int n = 0; n < 4; ++n)
#pragma unroll
        for (int j = 0; j < 4; ++j) {
          int row = row0 + wr * 64 + m * 16 + quad * 4 + j, col = col0 + wc * 64 + n * 16 + l15;
          P.z[(size_t)row * 2048 + col] = acc[m][n][j];
        }
  }
}

__device__ void phase_a(const Params& P, char* smem) {
  const int n0 = 192, n1 = n0 + 2112, n2 = n1 + 1, n3 = n2 + 3008, n4 = n3 + 384, n5 = n4 + 256, n6 = n5 + 2048;
  for (int id = blockIdx.x; id < n6; id += gridDim.x) {
    if (id < n0) modulation_task(P, id, smem);
    else if (id < n1) h2_task(P, id - n0, smem);
    else if (id < n2) rope_table_task(P);
    else if (id < n3) win_transpose_task(P, 0, id - n2, smem);
    else if (id < n4) {
      int i = id - n3, l = i / 192, r = i % 192, nt = r >> 3, kt = r & 7;
      transpose_tile(P.w_uq + (size_t)l * 512 * QW, QW, kt * 64, nt * 64, P.wT_uq + (size_t)l * QW * 512, 512, nt * 64, P.q_norm_g + l * 512, false, smem);
    } else if (id < n5) {
      int i = id - n4, l = i / 128, r = i % 128, nt = r >> 2, kt = r & 3;
      transpose_tile(P.w_ukv + (size_t)l * 256 * 2048, 2048, kt * 64, nt * 64, P.wT_ukv + (size_t)l * 2048 * 256, 256, nt * 64, P.kv_norm_g + l * 256, false, smem);
    } else {
      int i = id - n5, l = i / 1024, r = i % 1024, nt = r >> 5, kt = r & 31;
      const float* gk = (kt < 16) ? (P.grp_g_mla + l * 1024) : (P.grp_g_hy + l * 1024 - 1024);
      transpose_tile(P.w_out + (size_t)l * DM * DM, DM, kt * 64, nt * 64, P.wT_out + (size_t)l * DM * DM, DM, nt * 64, gk, false, smem);
    }
  }
}

#ifndef MINB
#define MINB 2
#endif
__global__ void __launch_bounds__(256, MINB) hymba_fwd(Params Pin) {
  extern __shared__ __attribute__((aligned(16))) char smem[];
  cg::grid_group grid = cg::this_grid();
#ifndef PM
#define PM 0xffff
#endif
  typedef const Params __attribute__((address_space(4))) * KP4;
#if defined(__HIP_DEVICE_COMPILE__)
#define GETP() ([&]() { KP4 kp = (KP4)__builtin_amdgcn_kernarg_segment_ptr(); asm volatile("" : "+s"(kp)); Params q = *kp; return q; }())
#else
#define GETP() Pin
#endif
  if (PM & 1) phase_a(GETP(), smem);
  grid.sync();
  if (PM & 2) phase_prenorm0(GETP());
  grid.sync();
#pragma unroll 1
  for (int l = 0; l < 2; ++l) {
#ifndef REP
#define REP 0
#endif
    const int r0 = Pin.reps[0], r1 = Pin.reps[1], r2 = Pin.reps[2], r3 = Pin.reps[3];
#pragma unroll 1
    for (int r = 0; r < r0; ++r) { phase_gemm_in(GETP(), l, smem); grid.sync(); }
#pragma unroll 1
    for (int r = 0; r < r1; ++r) { phase_d(GETP(), l, smem); grid.sync(); }
#pragma unroll 1
    for (int r = 0; r < r2; ++r) { phase_attn(GETP(), l, smem); grid.sync(); }
    if (PM & 32) phase_merge(GETP(), l, smem);
    grid.sync();
#pragma unroll 1
    for (int r = 0; r < r3; ++r) { phase_gemm_out(GETP(), l, smem); grid.sync(); }
    if (PM & 128) phase_post(GETP(), l);
    if (l == 0) grid.sync();
  }
}

extern "C" void kernel_launch(void* const* d_in, const int* in_sizes, int n_in, void* d_out, int out_size, void* d_ws, size_t ws_size,
                              hipStream_t stream) {
  static int grid_blocks = 0;
  if (grid_blocks == 0) {
    int dev = 0, cus = 0, per_cu = 0;
    hipGetDevice(&dev);
    hipDeviceGetAttribute(&cus, hipDeviceAttributeMultiprocessorCount, dev);
    if (hipFuncSetAttribute((const void*)hymba_fwd, hipFuncAttributeMaxDynamicSharedMemorySize, LDS_BYTES) != hipSuccess) {
      fprintf(stderr, "hipFuncSetAttribute failed\n"); grid_blocks = -1; return;
    }
    hipOccupancyMaxActiveBlocksPerMultiprocessor(&per_cu, (const void*)hymba_fwd, NT, LDS_BYTES);
    if (per_cu < 1) per_cu = 1;
    if (per_cu > 2) per_cu = 2;
    grid_blocks = cus * per_cu;
  }
  if (grid_blocks < 0) return;
  Params p{};
  const float** pin = (const float**)&p;
  for (int i = 0; i < 25; ++i) pin[i] = (const float*)d_in[i];
  p.out = (float*)d_out;
  char* ws = (char*)d_ws;
  size_t off = 0;
  auto take = [&](size_t bytes) { char* r = ws + off; off += (bytes + 255) & ~(size_t)255; return r; };
  p.wT_in = (bf16*)take((size_t)NPADW * DM * 2);
  p.wT_uq = (bf16*)take((size_t)2 * QW * 512 * 2);
  p.wT_ukv = (bf16*)take((size_t)2 * 2048 * 256 * 2);
  p.wT_out = (bf16*)take((size_t)2 * DM * DM * 2);
  p.mod = (float*)take((size_t)2 * 5 * 6144 * 4);
  p.h2T = (float*)take((size_t)2 * 64 * 4096 * 4);
  p.h2cT = (float*)take((size_t)64 * 256 * 4);
  p.rope = (float*)take((size_t)64 * 16 * 2 * 4);
  p.xh = (bf16*)take((size_t)TT * DM * 2);
  p.pa = (bf16*)take((size_t)TT * NPA * 2);
  p.pT = (bf16*)take((size_t)4 * NHYC * 4096 * 2);
  p.pchy = (bf16*)take((size_t)TC * NHYC * 2);
  p.z = (float*)p.pa;
  p.qbuf = (bf16*)take((size_t)TT * QW * 2);
  p.Kn = (bf16*)take((size_t)4 * 8 * LK * 128 * 2);
  p.kr = (bf16*)take((size_t)4 * LK * 64 * 2);
  p.vT = (bf16*)take((size_t)4 * 8 * 128 * LK * 2);
  p.yhT = (bf16*)take((size_t)4 * 1024 * 4096 * 2);
  p.ctx1 = (float*)take((size_t)TC * DM * 4);
  p.kfg = (float*)take((size_t)grid_blocks * 2 * 4096 * 8);
  if (off > ws_size) { fprintf(stderr, "workspace too small: need %zu have %zu\n", off, ws_size); return; }
#ifndef REPS
#define REPS 1, 1, 1, 1
#endif
  { const int rr[4] = {REPS}; for (int i = 0; i < 4; ++i) p.reps[i] = rr[i]; }
  void* args[] = {&p};
  hipError_t e = hipLaunchCooperativeKernel((void*)hymba_fwd, dim3(grid_blocks), dim3(NT), args, LDS_BYTES, stream);
  if (e != hipSuccess) fprintf(stderr, "cooperative launch failed: %s (grid %d)\n", hipGetErrorString(e), grid_blocks);
}
```

```cpp
#include <hip/hip_runtime.h>
#include <hip/hip_cooperative_groups.h>
#include <cstdio>
namespace cg = cooperative_groups;

typedef unsigned short bf16;
using bf16x8 = __attribute__((ext_vector_type(8))) short;
using f32x4 = __attribute__((ext_vector_type(4))) float;

constexpr int DM = 2048, SEQ = 4096, CTXL = 256;
constexpr int TX = 16384, TC = 1024, TT = 17408;
constexpr int NIN = 5952, NPA = 2944, NHYC = 3072, NPADW = 6016;
constexpr int LK = 4352;
constexpr int QW = 1536;
constexpr float EPSN = 1e-6f;
constexpr float QSCALE = 0.07216878364870322f * 1.4426950408889634f;
constexpr int LDS_BYTES = 69632;
constexpr int NT = 256;

struct Params {
  const float *x, *c, *ctx, *c_ctx, *ada_w, *ada_b, *pre_g, *w_in, *q_norm_g, *w_uq, *kv_norm_g, *w_ukv, *conv_w, *conv_b,
      *filt_w1, *filt_b1, *filt_freq, *filt_w2, *filt_b2, *filt_w3, *hy_D, *grp_g_mla, *grp_g_hy, *w_out, *post_g;
  float* out;
  bf16 *wT_in, *wT_uq, *wT_ukv, *wT_out;
  float *mod, *h2T, *h2cT, *rope;
  bf16 *xh, *pa, *pT, *pchy;
  float* z;
  bf16 *qbuf, *Kn, *kr, *vT, *yhT;
  float* ctx1;
  float* kfg;
  int reps[8];
};

__device__ __forceinline__ bf16 f2bf(float f) {
  unsigned u = __float_as_uint(f);
  u += 0x7fffu + ((u >> 16) & 1u);
  return (bf16)(u >> 16);
}
__device__ __forceinline__ float bf2f(bf16 h) { return __uint_as_float(((unsigned)h) << 16); }
__device__ __forceinline__ unsigned pack2(float a, float b) { return (unsigned)f2bf(a) | ((unsigned)f2bf(b) << 16); }
__device__ __forceinline__ float wave_sum(float v) {
#pragma unroll
  for (int o = 32; o > 0; o >>= 1) v += __shfl_xor(v, o);
  return v;
}
__device__ __forceinline__ int launder(int v) { asm volatile("" : "+v"(v)); return v; }
__device__ __forceinline__ float launderf(float v) { asm volatile("" : "+v"(v)); return v; }
__device__ __forceinline__ float siluf(float v) { return v / (1.f + __expf(-v)); }

#define HD __device__ __forceinline__
struct cf { float x, y; };
HD cf cmul(cf a, cf b) { return cf{a.x * b.x - a.y * b.y, a.x * b.y + a.y * b.x}; }
HD cf cmulc(cf a, cf b) { return cf{a.x * b.x + a.y * b.y, a.y * b.x - a.x * b.y}; }
HD cf cadd(cf a, cf b) { return cf{a.x + b.x, a.y + b.y}; }
HD cf csub(cf a, cf b) { return cf{a.x - b.x, a.y - b.y}; }
template <bool INV> HD void dft4(cf& a0, cf& a1, cf& a2, cf& a3) {
  cf s02 = cadd(a0, a2), d02 = csub(a0, a2), s13 = cadd(a1, a3), d13 = csub(a1, a3);
  cf r = INV ? cf{-d13.y, d13.x} : cf{d13.y, -d13.x};
  a0 = cadd(s02, s13); a2 = csub(s02, s13); a1 = cadd(d02, r); a3 = csub(d02, r);
}
#define W16C1 0.92387953251128674f
#define W16S1 0.38268343236508977f
#define W16R2 0.70710678118654752f
template <bool INV> HD cf w16(int m) {
  float c, s;
  switch (m) {
    case 0: c = 1.f; s = 0.f; break;
    case 1: c = W16C1; s = W16S1; break;
    case 2: c = W16R2; s = W16R2; break;
    case 3: c = W16S1; s = W16C1; break;
    case 4: c = 0.f; s = 1.f; break;
    case 6: c = -W16R2; s = W16R2; break;
    default: c = -W16C1; s = -W16S1; break;
  }
  return cf{c, INV ? s : -s};
}
template <bool INV> HD void dft16_nt(cf* x) {
#pragma unroll
  for (int b = 0; b < 4; ++b) dft4<INV>(x[b], x[4 + b], x[8 + b], x[12 + b]);
#pragma unroll
  for (int c = 1; c < 4; ++c)
#pragma unroll
    for (int b = 1; b < 4; ++b) x[4 * c + b] = cmul(x[4 * c + b], w16<INV>(b * c));
#pragma unroll
  for (int c = 0; c < 4; ++c) dft4<INV>(x[4 * c], x[4 * c + 1], x[4 * c + 2], x[4 * c + 3]);
}
template <bool INV> HD void dft16_tn(cf* x) {
#pragma unroll
  for (int c = 0; c < 4; ++c) dft4<INV>(x[4 * c], x[4 * c + 1], x[4 * c + 2], x[4 * c + 3]);
#pragma unroll
  for (int c = 1; c < 4; ++c)
#pragma unroll
    for (int b = 1; b < 4; ++b) x[4 * c + b] = cmul(x[4 * c + b], w16<INV>(b * c));
#pragma unroll
  for (int b = 0; b < 4; ++b) dft4<INV>(x[b], x[4 + b], x[8 + b], x[12 + b]);
}
#define KOF(r) (((r) >> 2) + 4 * ((r) & 3))
#define PADI(p) ((p) + ((p) >> 4))
struct FftTw { cf c1, c2, c4, c5; };
HD void fwd_p1(cf* x, int t, const FftTw& tw, cf* lds) {
  dft16_nt<false>(x);
  __builtin_amdgcn_sched_barrier(0);
  cf pw = cf{1.f, 0.f};
#pragma unroll
  for (int k = 0; k < 16; ++k) { lds[(t + (t >> 4)) + 272 * k] = cmul(x[KOF(k)], pw); pw = cmul(pw, tw.c1); if ((k & 3) == 3) __builtin_amdgcn_sched_barrier(0); }
}
HD void fwd_p2(cf* x, int t, const FftTw& tw, cf* lds) {
  int k1 = t >> 4, n2b = t & 15;
#pragma unroll
  for (int j = 0; j < 16; ++j) x[j] = lds[(272 * k1 + n2b) + 17 * j];
  __builtin_amdgcn_sched_barrier(0);
  dft16_nt<false>(x);
  __builtin_amdgcn_sched_barrier(0);
  cf pw = cf{1.f, 0.f};
#pragma unroll
  for (int k = 0; k < 16; ++k) { lds[(272 * k1 + n2b) + 17 * k] = cmul(x[KOF(k)], pw); pw = cmul(pw, tw.c2); __builtin_amdgcn_sched_barrier(0); }
}
HD void fwd_p3(cf* x, int t, cf* lds) {
#pragma unroll
  for (int j = 0; j < 16; ++j) x[j] = lds[17 * t + j];
  dft16_nt<false>(x);
}
HD void inv_p3(cf* x, int t, const FftTw& tw, cf* lds) {
  dft16_tn<true>(x);
  __builtin_amdgcn_sched_barrier(0);
  cf pw = cf{1.f, 0.f};
#pragma unroll
  for (int n = 0; n < 16; ++n) { lds[17 * t + n] = cmulc(x[n], pw); pw = cmul(pw, tw.c2); __builtin_amdgcn_sched_barrier(0); }
}
HD void inv_p2(cf* x, int t, const FftTw& tw, cf* lds) {
  int k1 = t >> 4, n2b = t & 15;
#pragma unroll
  for (int j = 0; j < 16; ++j) x[j] = lds[(272 * k1 + n2b) + 17 * j];
  dft16_nt<true>(x);
  __builtin_amdgcn_sched_barrier(0);
  cf pw = tw.c4;
#pragma unroll
  for (int k = 0; k < 16; ++k) { lds[(272 * k1 + n2b) + 17 * k] = cmulc(x[KOF(k)], pw); pw = cmul(pw, tw.c5); if ((k & 3) == 3) __builtin_amdgcn_sched_barrier(0); }
}
HD void inv_p1(cf* x, int t, cf* lds) {
#pragma unroll
  for (int r = 0; r < 16; ++r) x[r] = lds[(t + (t >> 4)) + 272 * KOF(r)];
  dft16_tn<true>(x);
}
HD void fft_fwd(cf* x, int t, const FftTw& tw0, cf* lds) {
  FftTw tw; tw.c1 = cf{launderf(tw0.c1.x), launderf(tw0.c1.y)}; tw.c2 = cf{launderf(tw0.c2.x), launderf(tw0.c2.y)}; tw.c4 = tw0.c4; tw.c5 = tw0.c5;
  fwd_p1(x, t, tw, lds); __syncthreads();
  fwd_p2(x, t, tw, lds); __syncthreads();
  fwd_p3(x, t, lds); __syncthreads();
}
HD void fft_inv(cf* x, int t, const FftTw& tw0, cf* lds) {
  FftTw tw; tw.c2 = cf{launderf(tw0.c2.x), launderf(tw0.c2.y)}; tw.c4 = cf{launderf(tw0.c4.x), launderf(tw0.c4.y)}; tw.c5 = cf{launderf(tw0.c5.x), launderf(tw0.c5.y)}; tw.c1 = tw0.c1;
  inv_p3(x, t, tw, lds); __syncthreads();
  inv_p2(x, t, tw, lds); __syncthreads();
  inv_p1(x, t, lds); __syncthreads();
}
HD cf cispi(float a) { float s, c; sincospif(a, &s, &c); return cf{c, s}; }

__device__ __forceinline__ void gemm_tile(const bf16* __restrict__ A, int lda, const bf16* __restrict__ Bt, int ldb, int K, char* smem,
                                          f32x4 (&acc)[4][4]) {
  const int tid = launder((int)threadIdx.x), lane = tid & 63, w = tid >> 6, wr = w >> 1, wc = w & 1, l15 = lane & 15, quad = lane >> 4;
#pragma unroll
  for (int m = 0; m < 4; ++m)
#pragma unroll
    for (int n = 0; n < 4; ++n) acc[m][n] = f32x4{0.f, 0.f, 0.f, 0.f};
  uint4 ra[4], rb[4];
  const int nk = K >> 6;
  const bf16* ga[4]; const bf16* gb[4]; int so[4];
#pragma unroll
  for (int q = 0; q < 4; ++q) {
    int id = tid + 256 * q, r = id >> 3, ch = id & 7;
    ga[q] = A + (size_t)r * lda + ch * 8;
    gb[q] = Bt + (size_t)r * ldb + ch * 8;
    so[q] = r * 128 + ((ch ^ (r & 7)) << 4);
  }
#pragma unroll
  for (int q = 0; q < 4; ++q) { ra[q] = *(const uint4*)(ga[q]); rb[q] = *(const uint4*)(gb[q]); }
#pragma unroll
  for (int q = 0; q < 4; ++q) { *(uint4*)(smem + so[q]) = ra[q]; *(uint4*)(smem + 16384 + so[q]) = rb[q]; }
  __syncthreads();
  for (int kt = 0; kt < nk; ++kt) {
    char* cur = smem + (kt & 1) * 32768;
    char* nxt = smem + ((kt + 1) & 1) * 32768;
    if (kt + 1 < nk) {
#pragma unroll
      for (int q = 0; q < 4; ++q) { ra[q] = *(const uint4*)(ga[q] + (kt + 1) * 64); rb[q] = *(const uint4*)(gb[q] + (kt + 1) * 64); }
    }
#pragma unroll
    for (int kk = 0; kk < 2; ++kk) {
      bf16x8 af[4], bfr[4];
#pragma unroll
      for (int m = 0; m < 4; ++m) {
        int r = wr * 64 + m * 16 + l15;
        af[m] = *(const bf16x8*)(cur + r * 128 + (((kk * 4 + quad) ^ (r & 7)) << 4));
      }
#pragma unroll
      for (int n = 0; n < 4; ++n) {
        int r = wc * 64 + n * 16 + l15;
        bfr[n] = *(const bf16x8*)(cur + 16384 + r * 128 + (((kk * 4 + quad) ^ (r & 7)) << 4));
      }
#pragma unroll
      for (int m = 0; m < 4; ++m)
#pragma unroll
        for (int n = 0; n < 4; ++n) acc[m][n] = __builtin_amdgcn_mfma_f32_16x16x32_bf16(af[m], bfr[n], acc[m][n], 0, 0, 0);
    }
    if (kt + 1 < nk) {
#pragma unroll
      for (int q = 0; q < 4; ++q) { *(uint4*)(nxt + so[q]) = ra[q]; *(uint4*)(nxt + 16384 + so[q]) = rb[q]; }
    }
    __syncthreads();
  }
}

__device__ void transpose_tile(const float* __restrict__ src, int ldsrc, int k0, int srccol0, bf16* __restrict__ dst, int lddst, int dstrow0,
                               const float* __restrict__ gk, bool zero, char* smem) {
  float* tl = (float*)smem;
  const int tid = launder((int)threadIdx.x);
#pragma unroll 4
  for (int i = 0; i < 16; ++i) {
    int kk = (tid >> 6) + 4 * i, nn = tid & 63;
    float v = zero ? 0.f : src[(size_t)(k0 + kk) * ldsrc + srccol0 + nn];
    if (gk) v *= gk[k0 + kk];
    tl[kk * 65 + nn] = v;
  }
  __syncthreads();
#pragma unroll
  for (int i = 0; i < 2; ++i) {
    int id = tid + 256 * i, nn = id >> 3, kc = id & 7;
    uint4 o;
    o.x = pack2(tl[(kc * 8 + 0) * 65 + nn], tl[(kc * 8 + 1) * 65 + nn]);
    o.y = pack2(tl[(kc * 8 + 2) * 65 + nn], tl[(kc * 8 + 3) * 65 + nn]);
    o.z = pack2(tl[(kc * 8 + 4) * 65 + nn], tl[(kc * 8 + 5) * 65 + nn]);
    o.w = pack2(tl[(kc * 8 + 6) * 65 + nn], tl[(kc * 8 + 7) * 65 + nn]);
    *(uint4*)(dst + (size_t)(dstrow0 + nn) * lddst + k0 + kc * 8) = o;
  }
  __syncthreads();
}
__device__ void win_transpose_task(const Params& P, int l, int task, char* smem) {
  int nt = task >> 5, kt = task & 31;
  int n0 = nt * 64;
  int srccol; bool zero = false;
  if (n0 < 1856) srccol = n0;
  else if (n0 < 2880) srccol = 4928 + (n0 - 1856);
  else if (n0 < 2944) { srccol = 0; zero = true; }
  else srccol = 1856 + (n0 - 2944);
  transpose_tile(P.w_in + (size_t)l * DM * NIN, NIN, kt * 64, srccol, P.wT_in, DM, n0, nullptr, zero, smem);
}
__device__ void modulation_task(const Params& P, int task, char* smem) {
  float* s = (float*)smem;
  float* red = s + 5 * 2048;
  const int tid = launder((int)threadIdx.x);
  int l = task / 96, cgp = task % 96;
  for (int i = tid; i < 5 * 2048; i += NT) {
    int v = i >> 11, k = i & 2047;
    float cv = (v < 4) ? P.c[v * 2048 + k] : P.c_ctx[k];
    s[i] = cv / (1.f + expf(-cv));
  }
  __syncthreads();
  int kg = tid >> 6, cj = tid & 63, col = cgp * 64 + cj;
  float acc[5] = {0.f, 0.f, 0.f, 0.f, 0.f};
  const float* wp = P.ada_w + ((size_t)l * 2048 + kg * 512) * 6144 + col;
  const float* sp = s + kg * 512;
#pragma unroll 8
  for (int k = 0; k < 512; ++k) {
    float wv = wp[(size_t)k * 6144];
#pragma unroll
    for (int v = 0; v < 5; ++v) acc[v] += sp[v * 2048 + k] * wv;
  }
#pragma unroll
  for (int v = 0; v < 5; ++v) red[(kg * 5 + v) * 64 + cj] = acc[v];
  __syncthreads();
  for (int i = tid; i < 320; i += NT) {
    int v = i >> 6, c2 = i & 63;
    float a = red[(0 * 5 + v) * 64 + c2] + red[(1 * 5 + v) * 64 + c2] + red[(2 * 5 + v) * 64 + c2] + red[(3 * 5 + v) * 64 + c2];
    int cc = cgp * 64 + c2;
    P.mod[(size_t)(l * 5 + v) * 6144 + cc] = a + P.ada_b[l * 6144 + cc];
  }
  __syncthreads();
}
__device__ void h2_task(const Params& P, int task, char* smem) {
  float* zf = (float*)smem;
  float* h1 = zf + 4 * 36;
  const int tid = launder((int)threadIdx.x), pos = tid >> 6, j = tid & 63;
  int which, n0;
  if (task < 1024) { which = 0; n0 = task * 4; }
  else if (task < 2048) { which = 1; n0 = (task - 1024) * 4; }
  else { which = 2; n0 = (task - 2048) * 4; }
  const int Lc = (which == 2) ? 256 : 4096;
  const int l = (which == 1) ? 1 : 0;
  const int n = n0 + pos;
  if (j < 33) {
    float v;
    if (j == 0) v = (float)n / (float)(Lc - 1);
    else {
      int k = (j - 1) & 15;
      float f = 1e-4f + (float)k * ((15.f - 1e-4f) / 15.f);
      float wpos = (6.283185307179586f * (float)n) / (float)Lc;
      float a = f * wpos;
      v = (j <= 16) ? cosf(a) : -sinf(a);
    }
    zf[pos * 36 + j] = v;
  }
  __syncthreads();
  float fr = P.filt_freq[l * 64 + j];
  float a = P.filt_b1[l * 64 + j];
#pragma unroll
  for (int i = 0; i < 33; ++i) a += zf[pos * 36 + i] * P.filt_w1[(l * 33 + i) * 64 + j];
  h1[pos * 64 + j] = sinf(fr * a);
  __syncthreads();
  float a2 = P.filt_b2[l * 64 + j];
#pragma unroll 8
  for (int i = 0; i < 64; ++i) a2 += h1[pos * 64 + i] * P.filt_w2[(l * 64 + i) * 64 + j];
  float hv = sinf(fr * a2);
  if (which == 2) P.h2cT[j * 256 + n] = hv;
  else P.h2T[((size_t)l * 64 + j) * 4096 + n] = hv;
  __syncthreads();
}
__device__ void rope_table_task(const Params& P) {
  for (int i = launder((int)threadIdx.x); i < 64 * 16; i += NT) {
    int pos = i >> 4, f = i & 15;
    float inv = powf(10000.f, -(float)f / 16.f);
    float ang = (float)pos * inv;
    P.rope[2 * i] = cosf(ang);
    P.rope[2 * i + 1] = sinf(ang);
  }
}

__device__ __forceinline__ void prenorm_store(const Params& P, const float4* v, int row, int l, int mv, int lane) {
  float ss = 0.f;
#pragma unroll
  for (int i = 0; i < 8; ++i) ss += v[i].x * v[i].x + v[i].y * v[i].y + v[i].z * v[i].z + v[i].w * v[i].w;
  ss = wave_sum(ss);
  float r = rsqrtf(ss * (1.f / 2048.f) + EPSN);
  const float* md = P.mod + (size_t)(l * 5 + mv) * 6144;
#pragma unroll
  for (int i = 0; i < 8; ++i) {
    int idx = (i * 64 + lane) * 4;
    float4 g = *(const float4*)(P.pre_g + l * 2048 + idx);
    float4 sh = *(const float4*)(md + idx);
    float4 sc = *(const float4*)(md + 2048 + idx);
    float o0 = v[i].x * r * g.x * (1.f + sc.x) + sh.x;
    float o1 = v[i].y * r * g.y * (1.f + sc.y) + sh.y;
    float o2 = v[i].z * r * g.z * (1.f + sc.z) + sh.z;
    float o3 = v[i].w * r * g.w * (1.f + sc.w) + sh.w;
    uint2 o; o.x = pack2(o0, o1); o.y = pack2(o2, o3);
    *(uint2*)(P.xh + (size_t)row * 2048 + idx) = o;
  }
}
__device__ void phase_prenorm0(const Params& P) {
  const int lane = launder((int)threadIdx.x) & 63, wv = launder((int)threadIdx.x) >> 6;
  for (int row = blockIdx.x * 4 + wv; row < TT; row += gridDim.x * 4) {
    const float* src = (row < TX) ? (P.x + (size_t)row * 2048) : (P.ctx + (size_t)(row - TX) * 2048);
    int mv = (row < TX) ? (row >> 12) : 4;
    float4 v[8];
#pragma unroll
    for (int i = 0; i < 8; ++i) v[i] = *(const float4*)(src + (i * 64 + lane) * 4);
    prenorm_store(P, v, row, 0, mv, lane);
  }
}
__device__ void phase_post(const Params& P, int l) {
  const int lane = launder((int)threadIdx.x) & 63, wv = launder((int)threadIdx.x) >> 6;
  const int nrows = (l == 0) ? TT : TX;
  for (int row = blockIdx.x * 4 + wv; row < nrows; row += gridDim.x * 4) {
    const bool isx = row < TX;
    int mv = isx ? (row >> 12) : 4;
    const float* zr = P.z + (size_t)row * 2048;
    const float* xo = (l == 0) ? (isx ? P.x + (size_t)row * 2048 : P.ctx + (size_t)(row - TX) * 2048) : (P.out + (size_t)row * 2048);
    float* xn = isx ? (P.out + (size_t)row * 2048) : (P.ctx1 + (size_t)(row - TX) * 2048);
    float4 zv[8];
    float ss = 0.f;
#pragma unroll
    for (int i = 0; i < 8; ++i) {
      zv[i] = *(const float4*)(zr + (i * 64 + lane) * 4);
      ss += zv[i].x * zv[i].x + zv[i].y * zv[i].y + zv[i].z * zv[i].z + zv[i].w * zv[i].w;
    }
    ss = wave_sum(ss);
    float r = rsqrtf(ss * (1.f / 2048.f) + EPSN);
    const float* gt = P.mod + (size_t)(l * 5 + mv) * 6144 + 4096;
#pragma unroll
    for (int i = 0; i < 8; ++i) {
      int idx = (i * 64 + lane) * 4;
      float4 xv = *(const float4*)(xo + idx);
      float4 g = *(const float4*)(gt + idx);
      float4 pg = *(const float4*)(P.post_g + l * 2048 + idx);
      zv[i].x = xv.x + g.x * zv[i].x * r * pg.x;
      zv[i].y = xv.y + g.y * zv[i].y * r * pg.y;
      zv[i].z = xv.z + g.z * zv[i].z * r * pg.z;
      zv[i].w = xv.w + g.w * zv[i].w * r * pg.w;
      *(float4*)(xn + idx) = zv[i];
    }
    if (l == 0) prenorm_store(P, zv, row, 1, mv, lane);
  }
  if (l == 0) {
  }
}

__device__ void gemm_in_task(const Params& P, int l, int mt, int nt, char* smem) {
  f32x4 acc[4][4];
  const int row0 = mt * 128, col0 = nt * 128;
  gemm_tile(P.xh + (size_t)row0 * DM, DM, P.wT_in + (size_t)col0 * DM, DM, DM, smem, acc);
  const int tid = launder((int)threadIdx.x), lane = tid & 63, w = tid >> 6, wr = w >> 1, wc = w & 1, l15 = lane & 15, quad = lane >> 4;
  const int rowbase = row0 + wr * 64, colbase = col0 + wc * 64;
  const bool isx = row0 < TX;
  if (colbase < NPA) {
    if (colbase == 768) {
#pragma unroll
      for (int m = 0; m < 4; ++m)
#pragma unroll
        for (int j = 0; j < 4; ++j) {
          int row = rowbase + m * 16 + quad * 4 + j;
          float v0 = acc[m][0][j], v1 = acc[m][1][j], v2 = acc[m][2][j], v3 = acc[m][3][j];
          int b, kk;
          if (isx) {
            int t = row & 4095; b = row >> 12; kk = 256 + t;
            float2 cs0 = *(const float2*)(P.rope + 2 * ((t >> 6) * 16 + l15));
            float2 cs1 = *(const float2*)(P.rope + 2 * ((t & 63) * 16 + l15));
            float a0 = v0 * cs0.x - v1 * cs0.y, a1 = v1 * cs0.x + v0 * cs0.y;
            float a2 = v2 * cs1.x - v3 * cs1.y, a3 = v3 * cs1.x + v2 * cs1.y;
            v0 = a0; v1 = a1; v2 = a2; v3 = a3;
          } else { int rc = row - TX; b = rc >> 8; kk = rc & 255; }
          bf16* dst = P.kr + ((size_t)b * LK + kk) * 64 + l15;
          dst[0] = f2bf(v0); dst[16] = f2bf(v1); dst[32] = f2bf(v2); dst[48] = f2bf(v3);
        }
    } else {
#pragma unroll
      for (int m = 0; m < 4; ++m)
#pragma unroll
        for (int n = 0; n < 4; ++n)
#pragma unroll
          for (int j = 0; j < 4; ++j) {
            int row = rowbase + m * 16 + quad * 4 + j, col = colbase + n * 16 + l15;
            P.pa[(size_t)row * NPA + col] = f2bf(acc[m][n][j]);
          }
    }
  } else {
    const int hc0 = colbase - NPA;
    if (isx) {
      const int b = row0 >> 12, t0 = (rowbase & 4095);
#pragma unroll
      for (int m = 0; m < 4; ++m)
#pragma unroll
        for (int n = 0; n < 4; ++n) {
          int hc = hc0 + n * 16 + l15, t = t0 + m * 16 + quad * 4;
          uint2 o; o.x = pack2(acc[m][n][0], acc[m][n][1]); o.y = pack2(acc[m][n][2], acc[m][n][3]);
          *(uint2*)(P.pT + ((size_t)b * NHYC + hc) * 4096 + t) = o;
        }
    } else {
#pragma unroll
      for (int m = 0; m < 4; ++m)
#pragma unroll
        for (int n = 0; n < 4; ++n)
#pragma unroll
          for (int j = 0; j < 4; ++j) {
            int row = rowbase + m * 16 + quad * 4 + j - TX, hc = hc0 + n * 16 + l15;
            P.pchy[(size_t)row * NHYC + hc] = f2bf(acc[m][n][j]);
          }
    }
  }
}
__device__ void phase_gemm_in(const Params& P, int l, char* smem) {
  const int nx = 128 * 47;
  const int nctx = 8 * ((l == 0) ? 47 : 23);
  for (int id = blockIdx.x; id < nx + nctx; id += gridDim.x) {
    int mt, nt;
    if (id < nx) { mt = (id / 376) * 8 + (id & 7); nt = (id % 376) >> 3; }
    else { int i2 = id - nx; mt = 128 + (i2 & 7); nt = i2 >> 3; }
    gemm_in_task(P, l, mt, nt, smem);
  }
}

__device__ void q_gemm_task(const Params& P, int l, int mt, int nt, char* smem) {
  float* rs = (float*)(smem + 65536);
  const int tid = launder((int)threadIdx.x), lane = tid & 63, w = tid >> 6, wr = w >> 1, wc = w & 1, l15 = lane & 15, quad = lane >> 4;
  const int row0 = mt * 128, col0 = nt * 128;
  for (int rr = 0; rr < 32; ++rr) {
    int r = w * 32 + rr;
    uint4 v = *(const uint4*)(P.pa + (size_t)(row0 + r) * NPA + lane * 8);
    float ss = 0.f;
    unsigned uu[4] = {v.x, v.y, v.z, v.w};
#pragma unroll
    for (int e = 0; e < 4; ++e) { float a = __uint_as_float(uu[e] << 16), b = __uint_as_float(uu[e] & 0xffff0000u); ss += a * a + b * b; }
    ss = wave_sum(ss);
    if (lane == 0) rs[r] = rsqrtf(ss * (1.f / 512.f) + EPSN) * QSCALE;
  }
  __syncthreads();
  f32x4 acc[4][4];
  gemm_tile(P.pa + (size_t)row0 * NPA, NPA, P.wT_uq + (size_t)l * QW * 512 + (size_t)col0 * 512, 512, 512, smem, acc);
  const int rowbase = row0 + wr * 64, colbase = col0 + wc * 64;
  const bool isx = row0 < TX;
  const bool ropet = isx && (((colbase >> 6) % 3) == 2);
#pragma unroll
  for (int m = 0; m < 4; ++m)
#pragma unroll
    for (int j = 0; j < 4; ++j) {
      int row = rowbase + m * 16 + quad * 4 + j;
      float sc = rs[row - row0];
      float v0 = acc[m][0][j] * sc, v1 = acc[m][1][j] * sc, v2 = acc[m][2][j] * sc, v3 = acc[m][3][j] * sc;
      if (ropet) {
        int t = row & 4095;
        float2 cs0 = *(const float2*)(P.rope + 2 * ((t >> 6) * 16 + l15));
        float2 cs1 = *(const float2*)(P.rope + 2 * ((t & 63) * 16 + l15));
        float a0 = v0 * cs0.x - v1 * cs0.y, a1 = v1 * cs0.x + v0 * cs0.y;
        float a2 = v2 * cs1.x - v3 * cs1.y, a3 = v3 * cs1.x + v2 * cs1.y;
        v0 = a0; v1 = a1; v2 = a2; v3 = a3;
      }
      bf16* dst = P.qbuf + (size_t)row * QW + colbase + l15;
      dst[0] = f2bf(v0); dst[16] = f2bf(v1); dst[32] = f2bf(v2); dst[48] = f2bf(v3);
    }
  __syncthreads();
}
__device__ void kv_gemm_task(const Params& P, int l, int mt, int nt, char* smem) {
  float* rs = (float*)(smem + 65536);
  const int tid = launder((int)threadIdx.x), lane = tid & 63, w = tid >> 6, wr = w >> 1, wc = w & 1, l15 = lane & 15, quad = lane >> 4;
  const int row0 = mt * 128, col0 = nt * 128;
  for (int rr = 0; rr < 32; ++rr) {
    int r = w * 32 + rr;
    uint2 v = *(const uint2*)(P.pa + (size_t)(row0 + r) * NPA + 512 + lane * 4);
    float a0 = __uint_as_float(v.x << 16), a1 = __uint_as_float(v.x & 0xffff0000u), a2 = __uint_as_float(v.y << 16), a3 = __uint_as_float(v.y & 0xffff0000u);
    float ss = wave_sum(a0 * a0 + a1 * a1 + a2 * a2 + a3 * a3);
    if (lane == 0) rs[r] = rsqrtf(ss * (1.f / 256.f) + EPSN);
  }
  __syncthreads();
  f32x4 acc[4][4];
  gemm_tile(P.pa + (size_t)row0 * NPA + 512, NPA, P.wT_ukv + (size_t)l * 2048 * 256 + (size_t)col0 * 256, 256, 256, smem, acc);
  const int rowbase = row0 + wr * 64;
  const int h = nt >> 1;
  int b, kk0;
  if (row0 < TX) { b = row0 >> 12; kk0 = 256 + (rowbase & 4095); }
  else { int rc = rowbase - TX; b = rc >> 8; kk0 = rc & 255; }
  if ((nt & 1) == 0) {
#pragma unroll
    for (int m = 0; m < 4; ++m)
#pragma unroll
      for (int j = 0; j < 4; ++j) {
        int rl = m * 16 + quad * 4 + j;
        float sc = rs[wr * 64 + rl];
        bf16* dst = P.Kn + (((size_t)b * 8 + h) * LK + kk0 + rl) * 128 + wc * 64 + l15;
#pragma unroll
        for (int n = 0; n < 4; ++n) dst[n * 16] = f2bf(acc[m][n][j] * sc);
      }
  } else {
#pragma unroll
    for (int m = 0; m < 4; ++m) {
      int rl = m * 16 + quad * 4;
      float s0 = rs[wr * 64 + rl], s1 = rs[wr * 64 + rl + 1], s2 = rs[wr * 64 + rl + 2], s3 = rs[wr * 64 + rl + 3];
#pragma unroll
      for (int n = 0; n < 4; ++n) {
        int d = wc * 64 + n * 16 + l15;
        uint2 o; o.x = pack2(acc[m][n][0] * s0, acc[m][n][1] * s1); o.y = pack2(acc[m][n][2] * s2, acc[m][n][3] * s3);
        *(uint2*)(P.vT + (((size_t)b * 8 + h) * 128 + d) * LK + kk0 + rl) = o;
      }
    }
  }
  __syncthreads();
}

__device__ __forceinline__ float conv3(const bf16* __restrict__ rowp, int n, float w0, float w1, float w2, float bb) {
  float a = bb + w1 * bf2f(rowp[n]);
  if (n > 0) a += w0 * bf2f(rowp[n - 1]);
  if (n < 4095) a += w2 * bf2f(rowp[n + 1]);
  return a;
}
__device__ __forceinline__ float convl(const bf16* rowp, int n, float w0, float w1, float w2, float bb) {
  float pm = bf2f(rowp[n > 0 ? n - 1 : 0]), pc = bf2f(rowp[n]), pp = bf2f(rowp[n < 4095 ? n + 1 : 4095]);
  return bb + w1 * pc + ((n > 0) ? w0 : 0.f) * pm + ((n < 4095) ? w2 : 0.f) * pp;
}
__device__ void hyena_x_task(const Params& P, int l, int c, char* smem) {
  cf* lds = (cf*)smem;
  cf* est = (cf*)(smem + 34816);
  float* hbx = (float*)(smem + 34816);
  float* w3s = (float*)(smem + 34816 + 32768);
  const int t = launder((int)threadIdx.x);
  FftTw tw;
  tw.c1 = cispi(-(float)t / 2048.f);
  tw.c2 = cispi(-(float)(t & 15) / 128.f);
  tw.c4 = cispi(-(float)((t & 15) * (t >> 4)) / 2048.f);
  tw.c5 = cispi(-(float)(t >> 4) / 128.f);
  const cf c8 = cispi(-(float)t / 4096.f);
  const cf w32 = cf{0.98078528040323043f, -0.19509032201612825f};
  if (t < 128) w3s[t] = P.filt_w3[((size_t)l * 64 + (t & 63)) * 2048 + (t >> 6) * 1024 + c];
  __syncthreads();
  cf* kfe = (cf*)P.kfg + (size_t)blockIdx.x * 8192;
  cf* kfo = kfe + 4096;
  {
    cf ke[16];
    float af[16], ab[16];
#pragma unroll
    for (int j = 0; j < 16; ++j) { af[j] = 0.f; ab[j] = 0.f; }
    const float* h2p = P.h2T + (size_t)l * 64 * 4096;
#pragma unroll 2
    for (int i = 0; i < 64; ++i) {
      float wf = w3s[i], wb = w3s[64 + i];
#pragma unroll
      for (int j = 0; j < 16; ++j) { float hv = h2p[i * 4096 + j * 256 + t]; af[j] += hv * wf; ab[j] += hv * wb; }
    }
    const float d0 = -15.350567286626973f, d1 = -3.0701134573253946f;
    const float adel = fabsf(d0 + (float)c * ((d1 - d0) / 1023.f));
#pragma unroll
    for (int j = 0; j < 16; ++j) {
      int n = 256 * j + t;
      float dec = expf(-((float)n * (1.f / 4095.f)) * adel);
      af[j] *= dec; ab[j] *= dec;
      hbx[n] = ab[j];
    }
    __syncthreads();
#pragma unroll
    for (int j = 0; j < 16; ++j) {
      int n = 256 * j + t;
      float k1 = (n == 0) ? 0.f : hbx[4096 - n];
      ke[j] = cf{af[j] + k1, 0.f};
      af[j] = af[j] - k1;
    }
    __syncthreads();
    fft_fwd(ke, t, tw, lds);
    { const int tl = launder(t); _Pragma("unroll") for (int r = 0; r < 16; ++r) kfe[r * 256 + tl] = ke[r]; }
    cf wn = cf{launderf(c8.x), launderf(c8.y)};
#pragma unroll
    for (int j = 0; j < 16; ++j) { ke[j] = cf{af[j] * wn.x, af[j] * wn.y}; wn = cmul(wn, w32); }
    fft_fwd(ke, t, tw, lds);
    { const int tl = launder(t); _Pragma("unroll") for (int r = 0; r < 16; ++r) kfo[r * 256 + tl] = ke[r]; }
  }
  const float cw10 = P.conv_w[(l * 3 + 0) * 3072 + 1024 + c], cw11 = P.conv_w[(l * 3 + 1) * 3072 + 1024 + c], cw12 = P.conv_w[(l * 3 + 2) * 3072 + 1024 + c];
  const float cwv0 = P.conv_w[(l * 3 + 0) * 3072 + 2048 + c], cwv1 = P.conv_w[(l * 3 + 1) * 3072 + 2048 + c], cwv2 = P.conv_w[(l * 3 + 2) * 3072 + 2048 + c];
  const float cw00 = P.conv_w[(l * 3 + 0) * 3072 + c], cw01 = P.conv_w[(l * 3 + 1) * 3072 + c], cw02 = P.conv_w[(l * 3 + 2) * 3072 + c];
  const float cb0 = P.conv_b[l * 3072 + c], cb1 = P.conv_b[l * 3072 + 1024 + c], cbv = P.conv_b[l * 3072 + 2048 + c];
  const float Dc = P.hy_D[l * 1024 + c];
  for (int pr = 0; pr < 2; ++pr) {
    const int b0 = 2 * pr, b1 = 2 * pr + 1;
    bf16* rows = (bf16*)(smem + 34816);
    {
      const int tl = launder(t);
#pragma unroll
      for (int q = 0; q < 8; ++q) {
        const int rr = q >> 1, ch = tl + 256 * (q & 1);
        const int bb = (rr >> 1) ? b1 : b0, grp = (rr & 1) ? 2048 : 1024;
        uint4 v = *(const uint4*)(P.pT + ((size_t)bb * NHYC + grp + c) * 4096 + ch * 8);
        *(uint4*)(rows + rr * 4096 + ch * 8) = v;
      }
    }
    __syncthreads();
    cf u[16], x[16];
#pragma unroll 1
    for (int j = 0; j < 16; ++j) {
      int n = 256 * j + t;
      float ua = convl(rows, n, cw10, cw11, cw12, cb1) * convl(rows + 4096, n, cwv0, cwv1, cwv2, cbv);
      float ub = convl(rows + 8192, n, cw10, cw11, cw12, cb1) * convl(rows + 12288, n, cwv0, cwv1, cwv2, cbv);
      lds[(t + (t >> 4)) + 272 * j] = cf{ua, ub};
    }
#pragma unroll
    for (int j = 0; j < 16; ++j) { u[j] = lds[(t + (t >> 4)) + 272 * j]; x[j] = u[j]; }
    __syncthreads();
    fft_fwd(x, t, tw, lds);
    { const int tl = launder(t); _Pragma("unroll") for (int r = 0; r < 16; ++r) x[r] = cmul(x[r], kfe[r * 256 + tl]); }
    fft_inv(x, t, tw, lds);
#pragma unroll
    for (int j = 0; j < 16; ++j) est[256 * j + t] = x[j];
    {
      cf wn = cf{launderf(c8.x), launderf(c8.y)};
#pragma unroll
      for (int j = 0; j < 16; ++j) { x[j] = cmul(u[j], wn); wn = cmul(wn, w32); }
    }
    fft_fwd(x, t, tw, lds);
    { const int tl = launder(t); _Pragma("unroll") for (int r = 0; r < 16; ++r) x[r] = cmul(x[r], kfo[r * 256 + tl]); }
    fft_inv(x, t, tw, lds);
    {
      cf wn = cf{launderf(c8.x), launderf(c8.y)};
#pragma unroll
      for (int j = 0; j < 16; ++j) {
        cf o = cmulc(x[j], wn);
        cf e = est[256 * j + t];
        est[256 * j + t] = cf{(e.x + o.x) * (1.f / 8192.f) + Dc * u[j].x, (e.y + o.y) * (1.f / 8192.f) + Dc * u[j].y};
        wn = cmul(wn, w32);
      }
    }
    bf16* r0 = (bf16*)smem;
    {
      const int tl = launder(t);
#pragma unroll
      for (int q = 0; q < 4; ++q) {
        const int rr = q >> 1, ch = tl + 256 * (q & 1);
        const int bb = rr ? b1 : b0;
        uint4 v = *(const uint4*)(P.pT + ((size_t)bb * NHYC + c) * 4096 + ch * 8);
        *(uint4*)(r0 + rr * 4096 + ch * 8) = v;
      }
    }
    __syncthreads();
    bf16* oa = P.yhT + ((size_t)b0 * 1024 + c) * 4096;
    bf16* ob = P.yhT + ((size_t)b1 * 1024 + c) * 4096;
#pragma unroll 1
    for (int j = 0; j < 16; ++j) {
      int n = 256 * j + t;
      cf yv = est[n];
      float xa = convl(r0, n, cw00, cw01, cw02, cb0), xb = convl(r0 + 4096, n, cw00, cw01, cw02, cb0);
      oa[n] = f2bf(xa * yv.x);
      ob[n] = f2bf(xb * yv.y);
    }
    __syncthreads();
  }
}
__device__ void hyena_ctx_task(const Params& P, int c, char* smem) {
  float* hf = (float*)smem;
  float* hb = hf + 256;
  float* us = hb + 256;
  const int t = launder((int)threadIdx.x);
  const int l = 0;
  float af = 0.f, ab = 0.f;
  for (int i = 0; i < 64; ++i) {
    float hv = P.h2cT[i * 256 + t];
    af += hv * P.filt_w3[((size_t)l * 64 + i) * 2048 + c];
    ab += hv * P.filt_w3[((size_t)l * 64 + i) * 2048 + 1024 + c];
  }
  const float d0 = -15.350567286626973f, d1 = -3.0701134573253946f;
  const float adel = fabsf(d0 + (float)c * ((d1 - d0) / 1023.f));
  float dec = expf(-((float)t / 255.f) * adel);
  hf[t] = af * dec; hb[t] = ab * dec;
  float x0c[4], uu[4];
#pragma unroll
  for (int b = 0; b < 4; ++b) {
    const bf16* base = P.pchy + (size_t)(b * 256) * NHYC;
    float cv[3];
#pragma unroll
    for (int g = 0; g < 3; ++g) {
      int col = g * 1024 + c;
      float a = P.conv_b[l * 3072 + col] + P.conv_w[(l * 3 + 1) * 3072 + col] * bf2f(base[(size_t)t * NHYC + col]);
      if (t > 0) a += P.conv_w[(l * 3 + 0) * 3072 + col] * bf2f(base[(size_t)(t - 1) * NHYC + col]);
      if (t < 255) a += P.conv_w[(l * 3 + 2) * 3072 + col] * bf2f(base[(size_t)(t + 1) * NHYC + col]);
      cv[g] = a;
    }
    x0c[b] = cv[0]; uu[b] = cv[1] * cv[2];
    us[b * 256 + t] = uu[b];
  }
  __syncthreads();
  float acc[4] = {0.f, 0.f, 0.f, 0.f};
  for (int s = 0; s < 256; ++s) {
    float k = (s <= t) ? hf[t - s] : hb[s - t];
#pragma unroll
    for (int b = 0; b < 4; ++b) acc[b] += k * us[b * 256 + s];
  }
  const float Dc = P.hy_D[l * 1024 + c];
#pragma unroll
  for (int b = 0; b < 4; ++b) {
    int row = TX + b * 256 + t;
    P.xh[(size_t)row * 2048 + 1024 + c] = f2bf(x0c[b] * (acc[b] + Dc * uu[b]));
  }
  __syncthreads();
}
__device__ void phase_d(const Params& P, int l, char* smem) {
  const int nhx = 1024, nhc = (l == 0) ? 1024 : 0;
  const int nqm = (l == 0) ? 136 : 128;
  const int nq = nqm * 12, nkv = 136 * 16;
  const int total = nhx + nhc + nq + nkv;
  for (int id = blockIdx.x; id < total; id += gridDim.x) {
    int i = id;
#ifndef PDM
#define PDM 15
#endif
    if (i < nhx) { if (PDM & 1) hyena_x_task(P, l, i, smem); continue; }
    i -= nhx;
    if (i < nhc) { if (PDM & 2) hyena_ctx_task(P, i, smem); continue; }
    i -= nhc;
    if (i < nq) { if (PDM & 4) q_gemm_task(P, l, i / 12, i % 12, smem); continue; }
    i -= nq;
    if (PDM & 8) kv_gemm_task(P, l, i >> 4, i & 15, smem);
  }
}

__device__ void attn_task(const Params& P, int b, int h, int qrow0, int nkt, char* smem) {
  char* Ks = smem;
  char* Vs = smem + 25600;
  const int tid = launder((int)threadIdx.x), lane = tid & 63, w = tid >> 6, l15 = lane & 15, quad = lane >> 4;
  bf16x8 qf[2][6];
#pragma unroll
  for (int m = 0; m < 2; ++m)
#pragma unroll
    for (int ks = 0; ks < 6; ++ks)
      qf[m][ks] = *(const bf16x8*)(P.qbuf + (size_t)(qrow0 + w * 32 + m * 16 + l15) * QW + h * 192 + ks * 32 + quad * 8);
  const bf16* Kg = P.Kn + ((size_t)b * 8 + h) * LK * 128;
  const bf16* Rg = P.kr + (size_t)b * LK * 64;
  const bf16* Vg = P.vT + ((size_t)b * 8 + h) * 128 * LK;
  uint4 sk[4], sr[2], sv[4];
  auto gload = [&](int kt) {
#pragma unroll
    for (int q = 0; q < 4; ++q) { int id = tid + 256 * q; int key = id >> 4, ch = id & 15; sk[q] = *(const uint4*)(Kg + (size_t)(kt * 64 + key) * 128 + ch * 8); }
#pragma unroll
    for (int q = 0; q < 2; ++q) { int id = tid + 256 * q; int key = id >> 3, ch = id & 7; sr[q] = *(const uint4*)(Rg + (size_t)(kt * 64 + key) * 64 + ch * 8); }
#pragma unroll
    for (int q = 0; q < 4; ++q) { int id = tid + 256 * q; int d = id >> 3, ch = id & 7; sv[q] = *(const uint4*)(Vg + (size_t)d * LK + kt * 64 + ch * 8); }
  };
  auto lstore = [&]() {
#pragma unroll
    for (int q = 0; q < 4; ++q) { int id = tid + 256 * q; int key = id >> 4, ch = id & 15; *(uint4*)(Ks + key * 400 + ch * 16) = sk[q]; }
#pragma unroll
    for (int q = 0; q < 2; ++q) { int id = tid + 256 * q; int key = id >> 3, ch = id & 7; *(uint4*)(Ks + key * 400 + 256 + ch * 16) = sr[q]; }
#pragma unroll
    for (int q = 0; q < 4; ++q) { int id = tid + 256 * q; int d = id >> 3, ch = id & 7; *(uint4*)(Vs + d * 144 + ch * 16) = sv[q]; }
  };
  f32x4 oacc[8][2];
#pragma unroll
  for (int nd = 0; nd < 8; ++nd) { oacc[nd][0] = f32x4{0.f, 0.f, 0.f, 0.f}; oacc[nd][1] = f32x4{0.f, 0.f, 0.f, 0.f}; }
  float mrow[2] = {-1e30f, -1e30f}, lrow[2] = {0.f, 0.f};
  gload(0);
  lstore();
  __syncthreads();
  for (int kt = 0; kt < nkt; ++kt) {
    f32x4 s[4][2];
#pragma unroll
    for (int n = 0; n < 4; ++n) { s[n][0] = f32x4{0.f, 0.f, 0.f, 0.f}; s[n][1] = f32x4{0.f, 0.f, 0.f, 0.f}; }
#pragma unroll
    for (int ks = 0; ks < 6; ++ks) {
#pragma unroll
      for (int n = 0; n < 4; ++n) {
        bf16x8 a = *(const bf16x8*)(Ks + (n * 16 + l15) * 400 + ks * 64 + quad * 16);
        s[n][0] = __builtin_amdgcn_mfma_f32_16x16x32_bf16(a, qf[0][ks], s[n][0], 0, 0, 0);
        s[n][1] = __builtin_amdgcn_mfma_f32_16x16x32_bf16(a, qf[1][ks], s[n][1], 0, 0, 0);
      }
      if (ks & 1) __builtin_amdgcn_sched_barrier(0);
    }
    bf16x8 pb[2][2];
#pragma unroll
    for (int m = 0; m < 2; ++m) {
      float mx = s[0][m][0];
#pragma unroll
      for (int n = 0; n < 4; ++n)
#pragma unroll
        for (int j = 0; j < 4; ++j) mx = fmaxf(mx, s[n][m][j]);
      mx = fmaxf(mx, __shfl_xor(mx, 16));
      mx = fmaxf(mx, __shfl_xor(mx, 32));
      float mn = fmaxf(mrow[m], mx);
      float alpha = exp2f(mrow[m] - mn);
      mrow[m] = mn;
      float ps = 0.f;
#pragma unroll
      for (int n = 0; n < 4; ++n)
#pragma unroll
        for (int j = 0; j < 4; ++j) { float p = exp2f(s[n][m][j] - mn); s[n][m][j] = p; ps += p; }
      lrow[m] = lrow[m] * alpha + ps;
#pragma unroll
      for (int nd = 0; nd < 8; ++nd) { oacc[nd][m][0] *= alpha; oacc[nd][m][1] *= alpha; oacc[nd][m][2] *= alpha; oacc[nd][m][3] *= alpha; }
#pragma unroll
      for (int k2 = 0; k2 < 2; ++k2) {
        uint4 pk;
        pk.x = pack2(s[2 * k2][m][0], s[2 * k2][m][1]); pk.y = pack2(s[2 * k2][m][2], s[2 * k2][m][3]);
        pk.z = pack2(s[2 * k2 + 1][m][0], s[2 * k2 + 1][m][1]); pk.w = pack2(s[2 * k2 + 1][m][2], s[2 * k2 + 1][m][3]);
        pb[m][k2] = *(bf16x8*)&pk;
      }
    }
    __builtin_amdgcn_sched_barrier(0);
#pragma unroll
    for (int nd = 0; nd < 8; ++nd) {
      if ((nd & 1) == 0) __builtin_amdgcn_sched_barrier(0);
#pragma unroll
      for (int k2 = 0; k2 < 2; ++k2) {
        const char* vp = Vs + (nd * 16 + l15) * 144 + k2 * 64 + quad * 8;
        uint2 lo = *(const uint2*)(vp), hi = *(const uint2*)(vp + 32);
        uint4 av = uint4{lo.x, lo.y, hi.x, hi.y};
        bf16x8 a = *(bf16x8*)&av;
        oacc[nd][0] = __builtin_amdgcn_mfma_f32_16x16x32_bf16(a, pb[0][k2], oacc[nd][0], 0, 0, 0);
        oacc[nd][1] = __builtin_amdgcn_mfma_f32_16x16x32_bf16(a, pb[1][k2], oacc[nd][1], 0, 0, 0);
      }
    }
    __syncthreads();
    if (kt + 1 < nkt) { gload(kt + 1); lstore(); }
    __syncthreads();
  }
#pragma unroll
  for (int m = 0; m < 2; ++m) {
    float lt = lrow[m];
    lt += __shfl_xor(lt, 16);
    lt += __shfl_xor(lt, 32);
    float inv = 1.f / lt;
    int row = qrow0 + w * 32 + m * 16 + l15;
#pragma unroll
    for (int nd = 0; nd < 8; ++nd) {
      uint2 o; o.x = pack2(oacc[nd][m][0] * inv, oacc[nd][m][1] * inv); o.y = pack2(oacc[nd][m][2] * inv, oacc[nd][m][3] * inv);
      *(uint2*)(P.xh + (size_t)row * 2048 + h * 128 + nd * 16 + quad * 4) = o;
    }
  }
}
__device__ void phase_attn(const Params& P, int l, char* smem) {
  const int nx = 1024, nc = (l == 0) ? 64 : 0;
  for (int id = blockIdx.x; id < nx + nc; id += gridDim.x) {
    if (id < nx) {
      int j = id >> 3;
      int bh = (id & 7) + 8 * (j >> 5), qt = j & 31;
      int b = bh >> 3, h = bh & 7;
      attn_task(P, b, h, b * 4096 + qt * 128, 68, smem);
    } else {
      int i = id - nx;
      int bh = i >> 1, qt = i & 1;
      int b = bh >> 3, h = bh & 7;
      attn_task(P, b, h, TX + b * 256 + qt * 128, 4, smem);
    }
  }
}

__device__ __forceinline__ void unpack8(uint4 v, float* f) {
  f[0] = __uint_as_float(v.x << 16); f[1] = __uint_as_float(v.x & 0xffff0000u);
  f[2] = __uint_as_float(v.y << 16); f[3] = __uint_as_float(v.y & 0xffff0000u);
  f[4] = __uint_as_float(v.z << 16); f[5] = __uint_as_float(v.z & 0xffff0000u);
  f[6] = __uint_as_float(v.w << 16); f[7] = __uint_as_float(v.w & 0xffff0000u);
}
__device__ __forceinline__ void merge_row(const Params& P, int row, const char* yh_lds  , int lane) {
  bf16* yr = P.xh + (size_t)row * 2048;
  const bf16* gr = P.pa + (size_t)row * NPA;
  float o[2][8], y[2][8];
  float so = 0.f, sy = 0.f;
#pragma unroll
  for (int i = 0; i < 2; ++i) {
    int col = i * 512 + lane * 8;
    unpack8(*(const uint4*)(yr + col), o[i]);
    uint4 yv = yh_lds ? *(const uint4*)(yh_lds + col * 2) : *(const uint4*)(yr + 1024 + col);
    unpack8(yv, y[i]);
#pragma unroll
    for (int e = 0; e < 8; ++e) { so += o[i][e] * o[i][e]; sy += y[i][e] * y[i][e]; }
  }
  so = wave_sum(so); sy = wave_sum(sy);
  float rm = rsqrtf(so * (1.f / 1024.f) + EPSN), rh = rsqrtf(sy * (1.f / 1024.f) + EPSN);
#pragma unroll
  for (int i = 0; i < 2; ++i) {
    int col = i * 512 + lane * 8;
    float gm[8], gh[8];
    unpack8(*(const uint4*)(gr + 832 + col), gm);
    unpack8(*(const uint4*)(gr + 1856 + col), gh);
    uint4 a, b;
    a.x = pack2(o[i][0] * rm * siluf(gm[0]), o[i][1] * rm * siluf(gm[1]));
    a.y = pack2(o[i][2] * rm * siluf(gm[2]), o[i][3] * rm * siluf(gm[3]));
    a.z = pack2(o[i][4] * rm * siluf(gm[4]), o[i][5] * rm * siluf(gm[5]));
    a.w = pack2(o[i][6] * rm * siluf(gm[6]), o[i][7] * rm * siluf(gm[7]));
    b.x = pack2(y[i][0] * rh * siluf(gh[0]), y[i][1] * rh * siluf(gh[1]));
    b.y = pack2(y[i][2] * rh * siluf(gh[2]), y[i][3] * rh * siluf(gh[3]));
    b.z = pack2(y[i][4] * rh * siluf(gh[4]), y[i][5] * rh * siluf(gh[5]));
    b.w = pack2(y[i][6] * rh * siluf(gh[6]), y[i][7] * rh * siluf(gh[7]));
    *(uint4*)(yr + col) = a;
    *(uint4*)(yr + 1024 + col) = b;
  }
}
__device__ void merge_x_task(const Params& P, int task, char* smem) {
  const int tid = launder((int)threadIdx.x), lane = tid & 63, w = tid >> 6;
  const int b = task >> 7, tt = task & 127;
  constexpr int RS = 2064;
#pragma unroll 4
  for (int i = 0; i < 16; ++i) {
    int id = tid + 256 * i, cch = id >> 2, q = id & 3;
    uint4 v = *(const uint4*)(P.yhT + ((size_t)b * 1024 + cch) * 4096 + tt * 32 + q * 8);
    unsigned uu[4] = {v.x, v.y, v.z, v.w};
#pragma unroll
    for (int e = 0; e < 4; ++e) {
      *(bf16*)(smem + (q * 8 + 2 * e) * RS + cch * 2) = (bf16)(uu[e] & 0xffffu);
      *(bf16*)(smem + (q * 8 + 2 * e + 1) * RS + cch * 2) = (bf16)(uu[e] >> 16);
    }
  }
  __syncthreads();
  for (int rr = 0; rr < 8; ++rr) {
    int tk = w * 8 + rr;
    merge_row(P, b * 4096 + tt * 32 + tk, smem + tk * RS, lane);
  }
  __syncthreads();
}
__device__ void phase_merge(const Params& P, int l, char* smem) {
  const int nx = 512, nc = (l == 0) ? 256 : 0, nw = (l == 0) ? 3008 : 0;
  for (int id = blockIdx.x; id < nx + nc + nw; id += gridDim.x) {
    if (id < nx) merge_x_task(P, id, smem);
    else if (id < nx + nc) { int row = TX + (id - nx) * 4 + (launder((int)threadIdx.x) >> 6); merge_row(P, row, nullptr, launder((int)threadIdx.x) & 63); }
    else win_transpose_task(P, 1, id - nx - nc, smem);
  }
}

__device__ void phase_gemm_out(const Params& P, int l, char* smem) {
  const int nm = (l == 0) ? 136 : 128;
  for (int id = blockIdx.x; id < nm * 16; id += gridDim.x) {
    int mt = (id / 128) * 8 + (id & 7), nt = (id & 127) >> 3;
    f32x4 acc[4][4];
    const int row0 = mt * 128, col0 = nt * 128;
    gemm_tile(P.xh + (size_t)row0 * DM, DM, P.wT_out + (size_t)l * DM * DM + (size_t)col0 * DM, DM, DM, smem, acc);
    const int tid = launder((int)threadIdx.x), lane = tid & 63, w = tid >> 6, wr = w >> 1, wc = w & 1, l15 = lane & 15, quad = lane >> 4;
#pragma unroll
    for (int m = 0; m < 4; ++m)
#pragma unroll
      for (int n = 0; n < 4; ++n)
#pragma unroll
        for (int j = 0; j < 4; ++j) {
          int row = row0 + wr * 64 + m * 16 + quad * 4 + j, col = col0 + wc * 64 + n * 16 + l15;
          P.z[(size_t)row * 2048 + col] = acc[m][n][j];
        }
  }
}

__device__ void phase_a(const Params& P, char* smem) {
  const int n0 = 192, n1 = n0 + 2112, n2 = n1 + 1, n3 = n2 + 3008, n4 = n3 + 384, n5 = n4 + 256, n6 = n5 + 2048;
  for (int id = blockIdx.x; id < n6; id += gridDim.x) {
    if (id < n0) modulation_task(P, id, smem);
    else if (id < n1) h2_task(P, id - n0, smem);
    else if (id < n2) rope_table_task(P);
    else if (id < n3) win_transpose_task(P, 0, id - n2, smem);
    else if (id < n4) {
      int i = id - n3, l = i / 192, r = i % 192, nt = r >> 3, kt = r & 7;
      transpose_tile(P.w_uq + (size_t)l * 512 * QW, QW, kt * 64, nt * 64, P.wT_uq + (size_t)l * QW * 512, 512, nt * 64, P.q_norm_g + l * 512, false, smem);
    } else if (id < n5) {
      int i = id - n4, l = i / 128, r = i % 128, nt = r >> 2, kt = r & 3;
      transpose_tile(P.w_ukv + (size_t)l * 256 * 2048, 2048, kt * 64, nt * 64, P.wT_ukv + (size_t)l * 2048 * 256, 256, nt * 64, P.kv_norm_g + l * 256, false, smem);
    } else {
      int i = id - n5, l = i / 1024, r = i % 1024, nt = r >> 5, kt = r & 31;
      const float* gk = (kt < 16) ? (P.grp_g_mla + l * 1024) : (P.grp_g_hy + l * 1024 - 1024);
      transpose_tile(P.w_out + (size_t)l * DM * DM, DM, kt * 64, nt * 64, P.wT_out + (size_t)l * DM * DM, DM, nt * 64, gk, false, smem);
    }
  }
}

#ifndef MINB
#define MINB 2
#endif
__global__ void __launch_bounds__(256, MINB) hymba_fwd(Params Pin) {
  extern __shared__ __attribute__((aligned(16))) char smem[];
  cg::grid_group grid = cg::this_grid();
#ifndef PM
#define PM 0xffff
#endif
  typedef const Params __attribute__((address_space(4))) * KP4;
#if defined(__HIP_DEVICE_COMPILE__)
#define GETP() ([&]() { KP4 kp = (KP4)__builtin_amdgcn_kernarg_segment_ptr(); asm volatile("" : "+s"(kp)); Params q = *kp; return q; }())
#else
#define GETP() Pin
#endif
  if (PM & 1) phase_a(GETP(), smem);
  grid.sync();
  if (PM & 2) phase_prenorm0(GETP());
  grid.sync();
#pragma unroll 1
  for (int l = 0; l < 2; ++l) {
#ifndef REP
#define REP 0
#endif
    const int r0 = Pin.reps[0], r1 = Pin.reps[1], r2 = Pin.reps[2], r3 = Pin.reps[3];
#pragma unroll 1
    for (int r = 0; r < r0; ++r) { phase_gemm_in(GETP(), l, smem); grid.sync(); }
#pragma unroll 1
    for (int r = 0; r < r1; ++r) { phase_d(GETP(), l, smem); grid.sync(); }
#pragma unroll 1
    for (int r = 0; r < r2; ++r) { phase_attn(GETP(), l, smem); grid.sync(); }
    if (PM & 32) phase_merge(GETP(), l, smem);
    grid.sync();
#pragma unroll 1
    for (int r = 0; r < r3; ++r) { phase_gemm_out(GETP(), l, smem); grid.sync(); }
    if (PM & 128) phase_post(GETP(), l);
    if (l == 0) grid.sync();
  }
}

extern "C" void kernel_launch(void* const* d_in, const int* in_sizes, int n_in, void* d_out, int out_size, void* d_ws, size_t ws_size,
                              hipStream_t stream) {
  static int grid_blocks = 0;
  if (grid_blocks == 0) {
    int dev = 0, cus = 0, per_cu = 0;
    hipGetDevice(&dev);
    hipDeviceGetAttribute(&cus, hipDeviceAttributeMultiprocessorCount, dev);
    if (hipFuncSetAttribute((const void*)hymba_fwd, hipFuncAttributeMaxDynamicSharedMemorySize, LDS_BYTES) != hipSuccess) {
      fprintf(stderr, "hipFuncSetAttribute failed\n"); grid_blocks = -1; return;
    }
    hipOccupancyMaxActiveBlocksPerMultiprocessor(&per_cu, (const void*)hymba_fwd, NT, LDS_BYTES);
    if (per_cu < 1) per_cu = 1;
    if (per_cu > 2) per_cu = 2;
    grid_blocks = cus * per_cu;
  }
  if (grid_blocks < 0) return;
  Params p{};
  const float** pin = (const float**)&p;
  for (int i = 0; i < 25; ++i) pin[i] = (const float*)d_in[i];
  p.out = (float*)d_out;
  char* ws = (char*)d_ws;
  size_t off = 0;
  auto take = [&](size_t bytes) { char* r = ws + off; off += (bytes + 255) & ~(size_t)255; return r; };
  p.wT_in = (bf16*)take((size_t)NPADW * DM * 2);
  p.wT_uq = (bf16*)take((size_t)2 * QW * 512 * 2);
  p.wT_ukv = (bf16*)take((size_t)2 * 2048 * 256 * 2);
  p.wT_out = (bf16*)take((size_t)2 * DM * DM * 2);
  p.mod = (float*)take((size_t)2 * 5 * 6144 * 4);
  p.h2T = (float*)take((size_t)2 * 64 * 4096 * 4);
  p.h2cT = (float*)take((size_t)64 * 256 * 4);
  p.rope = (float*)take((size_t)64 * 16 * 2 * 4);
  p.xh = (bf16*)take((size_t)TT * DM * 2);
  p.pa = (bf16*)take((size_t)TT * NPA * 2);
  p.pT = (bf16*)take((size_t)4 * NHYC * 4096 * 2);
  p.pchy = (bf16*)take((size_t)TC * NHYC * 2);
  p.z = (float*)p.pa;
  p.qbuf = (bf16*)take((size_t)TT * QW * 2);
  p.Kn = (bf16*)take((size_t)4 * 8 * LK * 128 * 2);
  p.kr = (bf16*)take((size_t)4 * LK * 64 * 2);
  p.vT = (bf16*)take((size_t)4 * 8 * 128 * LK * 2);
  p.yhT = (bf16*)take((size_t)4 * 1024 * 4096 * 2);
  p.ctx1 = (float*)take((size_t)TC * DM * 4);
  p.kfg = (float*)take((size_t)grid_blocks * 2 * 4096 * 8);
  if (off > ws_size) { fprintf(stderr, "workspace too small: need %zu have %zu\n", off, ws_size); return; }
#ifndef REPS
#define REPS 1, 1, 1, 1
#endif
  { const int rr[4] = {REPS}; for (int i = 0; i < 4; ++i) p.reps[i] = rr[i]; }
  void* args[] = {&p};
  hipError_t e = hipLaunchCooperativeKernel((void*)hymba_fwd, dim3(grid_blocks), dim3(NT), args, LDS_BYTES, stream);
  if (e != hipSuccess) fprintf(stderr, "cooperative launch failed: %s (grid %d)\n", hipGetErrorString(e), grid_blocks);
}
```

```cpp
#include <hip/hip_runtime.h>
#include <hip/hip_cooperative_groups.h>
#include <cstdio>
namespace cg = cooperative_groups;

typedef unsigned short bf16;
using bf16x8 = __attribute__((ext_vector_type(8))) short;
using f32x4 = __attribute__((ext_vector_type(4))) float;

constexpr int DM = 2048, SEQ = 4096, CTXL = 256;
constexpr int TX = 16384, TC = 1024, TT = 17408;
constexpr int NIN = 5952, NPA = 2944, NHYC = 3072, NPADW = 6144;
constexpr int LK = 4352;
constexpr int QW = 1536;
constexpr float EPSN = 1e-6f;
constexpr float QSCALE = 0.07216878364870322f * 1.4426950408889634f;
constexpr int HALF_LDS = 69632;
constexpr int LDS_BYTES = 2 * HALF_LDS + 256;
constexpr int NT = 512;
#define VHALF (__builtin_amdgcn_readfirstlane((int)(threadIdx.x >> 8)))
#define VBID ((int)blockIdx.x + VHALF * (int)gridDim.x)
#define VGRID ((int)gridDim.x * 2)

struct Params {
  const float *x, *c, *ctx, *c_ctx, *ada_w, *ada_b, *pre_g, *w_in, *q_norm_g, *w_uq, *kv_norm_g, *w_ukv, *conv_w, *conv_b,
      *filt_w1, *filt_b1, *filt_freq, *filt_w2, *filt_b2, *filt_w3, *hy_D, *grp_g_mla, *grp_g_hy, *w_out, *post_g;
  float* out;
  bf16 *wT_in, *wT_uq, *wT_ukv, *wT_out;
  float *mod, *h2cT, *rope;
  bf16* h2T;
  bf16 *xh, *pa, *pT, *pchy;
  float* z;
  bf16 *qbuf, *Kn, *kr, *vT, *yhT;
  float* ctx1;
  float* kfg;
  unsigned* bar;
  int reps[8];
};

extern __shared__ __attribute__((aligned(1024))) char smem_dyn_[];
__device__ __forceinline__ void half_sync() {
  __builtin_amdgcn_fence(__ATOMIC_RELEASE, "workgroup");
  volatile __attribute__((address_space(3))) unsigned* ctr =
      (volatile __attribute__((address_space(3))) unsigned*)(smem_dyn_ + LDS_BYTES - 64) + VHALF * 4;
  if ((threadIdx.x & 63) == 0) {
    unsigned old = __hip_atomic_fetch_add((__attribute__((address_space(3))) unsigned*)ctr, 1u, __ATOMIC_RELAXED, __HIP_MEMORY_SCOPE_WORKGROUP);
    unsigned target = (old & ~3u) + 4u;
    while ((int)(__hip_atomic_load((__attribute__((address_space(3))) unsigned*)ctr, __ATOMIC_RELAXED, __HIP_MEMORY_SCOPE_WORKGROUP) - target) < 0) __builtin_amdgcn_s_sleep(1);
  }
  __builtin_amdgcn_fence(__ATOMIC_ACQUIRE, "workgroup");
}
#define HSYNC() half_sync()

__device__ __forceinline__ bf16 f2bf(float f) {
  unsigned u = __float_as_uint(f);
  u += 0x7fffu + ((u >> 16) & 1u);
  return (bf16)(u >> 16);
}
__device__ __forceinline__ float bf2f(bf16 h) { return __uint_as_float(((unsigned)h) << 16); }
__device__ __forceinline__ unsigned pack2(float a, float b) { unsigned r; asm volatile("v_cvt_pk_bf16_f32 %0, %1, %2" : "=v"(r) : "v"(a), "v"(b)); return r; }
__device__ __forceinline__ float wave_sum(float v) {
#pragma unroll
  for (int o = 32; o > 0; o >>= 1) v += __shfl_xor(v, o);
  return v;
}
__device__ __forceinline__ int launder(int v) { asm volatile("" : "+v"(v)); return v; }
__device__ __forceinline__ float launderf(float v) { asm volatile("" : "+v"(v)); return v; }
__device__ __forceinline__ float vmax(float a, float b) { float r; asm("v_max_f32 %0, %1, %2" : "=v"(r) : "v"(a), "v"(b)); return r; }
__device__ __forceinline__ float vmax3(float a, float b, float c) { float r; asm("v_max3_f32 %0, %1, %2, %3" : "=v"(r) : "v"(a), "v"(b), "v"(c)); return r; }
__device__ __forceinline__ float siluf(float v) { return v / (1.f + __expf(-v)); }

#define HD __device__ __forceinline__
struct cf { float x, y; };
HD cf cmul(cf a, cf b) { return cf{a.x * b.x - a.y * b.y, a.x * b.y + a.y * b.x}; }
HD cf cmulc(cf a, cf b) { return cf{a.x * b.x + a.y * b.y, a.y * b.x - a.x * b.y}; }
HD cf cadd(cf a, cf b) { return cf{a.x + b.x, a.y + b.y}; }
HD cf csub(cf a, cf b) { return cf{a.x - b.x, a.y - b.y}; }
template <bool INV> HD void dft4(cf& a0, cf& a1, cf& a2, cf& a3) {
  cf s02 = cadd(a0, a2), d02 = csub(a0, a2), s13 = cadd(a1, a3), d13 = csub(a1, a3);
  cf r = INV ? cf{-d13.y, d13.x} : cf{d13.y, -d13.x};
  a0 = cadd(s02, s13); a2 = csub(s02, s13); a1 = cadd(d02, r); a3 = csub(d02, r);
}
#define W16C1 0.92387953251128674f
#define W16S1 0.38268343236508977f
#define W16R2 0.70710678118654752f
template <bool INV> HD cf w16(int m) {
  float c, s;
  switch (m) {
    case 0: c = 1.f; s = 0.f; break;
    case 1: c = W16C1; s = W16S1; break;
    case 2: c = W16R2; s = W16R2; break;
    case 3: c = W16S1; s = W16C1; break;
    case 4: c = 0.f; s = 1.f; break;
    case 6: c = -W16R2; s = W16R2; break;
    default: c = -W16C1; s = -W16S1; break;
  }
  return cf{c, INV ? s : -s};
}
template <bool INV> HD void dft16_nt(cf* x) {
#pragma unroll
  for (int b = 0; b < 4; ++b) dft4<INV>(x[b], x[4 + b], x[8 + b], x[12 + b]);
#pragma unroll
  for (int c = 1; c < 4; ++c)
#pragma unroll
    for (int b = 1; b < 4; ++b) x[4 * c + b] = cmul(x[4 * c + b], w16<INV>(b * c));
#pragma unroll
  for (int c = 0; c < 4; ++c) dft4<INV>(x[4 * c], x[4 * c + 1], x[4 * c + 2], x[4 * c + 3]);
}
template <bool INV> HD void dft16_tn(cf* x) {
#pragma unroll
  for (int c = 0; c < 4; ++c) dft4<INV>(x[4 * c], x[4 * c + 1], x[4 * c + 2], x[4 * c + 3]);
#pragma unroll
  for (int c = 1; c < 4; ++c)
#pragma unroll
    for (int b = 1; b < 4; ++b) x[4 * c + b] = cmul(x[4 * c + b], w16<INV>(b * c));
#pragma unroll
  for (int b = 0; b < 4; ++b) dft4<INV>(x[b], x[4 + b], x[8 + b], x[12 + b]);
}
#define KOF(r) (((r) >> 2) + 4 * ((r) & 3))
#define PADI(p) ((p) + ((p) >> 4))
struct FftTw { cf c1, c2, c4, c5; };
HD void fwd_p1(cf* x, int t, const FftTw& tw, cf* lds) {
  dft16_nt<false>(x);
  __builtin_amdgcn_sched_barrier(0);
  cf pw = cf{1.f, 0.f};
#pragma unroll
  for (int k = 0; k < 16; ++k) { lds[(t + (t >> 4)) + 272 * k] = cmul(x[KOF(k)], pw); pw = cmul(pw, tw.c1); if ((k & 3) == 3) __builtin_amdgcn_sched_barrier(0); }
}
HD void fwd_p2(cf* x, int t, const FftTw& tw, cf* lds) {
  int k1 = t >> 4, n2b = t & 15;
#pragma unroll
  for (int j = 0; j < 16; ++j) x[j] = lds[(272 * k1 + n2b) + 17 * j];
  __builtin_amdgcn_sched_barrier(0);
  dft16_nt<false>(x);
  __builtin_amdgcn_sched_barrier(0);
  cf pw = cf{1.f, 0.f};
#pragma unroll
  for (int k = 0; k < 16; ++k) { lds[(272 * k1 + n2b) + 17 * k] = cmul(x[KOF(k)], pw); pw = cmul(pw, tw.c2); __builtin_amdgcn_sched_barrier(0); }
}
HD void fwd_p3(cf* x, int t, cf* lds) {
#pragma unroll
  for (int j = 0; j < 16; ++j) x[j] = lds[17 * t + j];
  dft16_nt<false>(x);
}
HD void inv_p3(cf* x, int t, const FftTw& tw, cf* lds) {
  dft16_tn<true>(x);
  __builtin_amdgcn_sched_barrier(0);
  cf pw = cf{1.f, 0.f};
#pragma unroll
  for (int n = 0; n < 16; ++n) { lds[17 * t + n] = cmulc(x[n], pw); pw = cmul(pw, tw.c2); __builtin_amdgcn_sched_barrier(0); }
}
HD void inv_p2(cf* x, int t, const FftTw& tw, cf* lds) {
  int k1 = t >> 4, n2b = t & 15;
#pragma unroll
  for (int j = 0; j < 16; ++j) x[j] = lds[(272 * k1 + n2b) + 17 * j];
  dft16_nt<true>(x);
  __builtin_amdgcn_sched_barrier(0);
  cf pw = tw.c4;
#pragma unroll
  for (int k = 0; k < 16; ++k) { lds[(272 * k1 + n2b) + 17 * k] = cmulc(x[KOF(k)], pw); pw = cmul(pw, tw.c5); if ((k & 3) == 3) __builtin_amdgcn_sched_barrier(0); }
}
HD void inv_p1(cf* x, int t, cf* lds) {
#pragma unroll
  for (int r = 0; r < 16; ++r) x[r] = lds[(t + (t >> 4)) + 272 * KOF(r)];
  dft16_tn<true>(x);
}
HD void fft_fwd(cf* x, int t, const FftTw& tw0, cf* lds) {
  FftTw tw; tw.c1 = cf{launderf(tw0.c1.x), launderf(tw0.c1.y)}; tw.c2 = cf{launderf(tw0.c2.x), launderf(tw0.c2.y)}; tw.c4 = tw0.c4; tw.c5 = tw0.c5;
  fwd_p1(x, t, tw, lds); __syncthreads();
  fwd_p2(x, t, tw, lds); __syncthreads();
  fwd_p3(x, t, lds); __syncthreads();
}
HD void fft_inv(cf* x, int t, const FftTw& tw0, cf* lds) {
  FftTw tw; tw.c2 = cf{launderf(tw0.c2.x), launderf(tw0.c2.y)}; tw.c4 = cf{launderf(tw0.c4.x), launderf(tw0.c4.y)}; tw.c5 = cf{launderf(tw0.c5.x), launderf(tw0.c5.y)}; tw.c1 = tw0.c1;
  inv_p3(x, t, tw, lds); __syncthreads();
  inv_p2(x, t, tw, lds); __syncthreads();
  inv_p1(x, t, lds); __syncthreads();
}
HD cf cispi(float a) { float s, c; sincospif(a, &s, &c); return cf{c, s}; }

__device__ __forceinline__ void gemm_tile(const bf16* __restrict__ A, int lda, const bf16* __restrict__ Bt, int ldb, int K, char* smem,
                                          f32x4 (&acc)[4][4]) {
  const int tid = launder((int)threadIdx.x & 255), lane = tid & 63, w = tid >> 6, wr = w >> 1, wc = w & 1, l15 = lane & 15, quad = lane >> 4;
#pragma unroll
  for (int m = 0; m < 4; ++m)
#pragma unroll
    for (int n = 0; n < 4; ++n) acc[m][n] = f32x4{0.f, 0.f, 0.f, 0.f};
  uint4 ra_0, ra_1, ra_2, ra_3, rb_0, rb_1, rb_2, rb_3;
  const int nk = K >> 6;
  const int r0 = tid >> 3, ch = tid & 7;
  const int goa = r0 * lda + ch * 8, gob = r0 * ldb + ch * 8;
  const int so0 = r0 * 128 + ((ch ^ (r0 & 7)) << 4);
#define GT_LOAD(kt) do { const bf16* ap = A + (kt) * 64 + goa; const bf16* bp = Bt + (kt) * 64 + gob; \
    ra_0 = *(const uint4*)(ap); rb_0 = *(const uint4*)(bp); ra_1 = *(const uint4*)(ap + 32 * lda); rb_1 = *(const uint4*)(bp + 32 * ldb); \
    ra_2 = *(const uint4*)(ap + 64 * lda); rb_2 = *(const uint4*)(bp + 64 * ldb); ra_3 = *(const uint4*)(ap + 96 * lda); rb_3 = *(const uint4*)(bp + 96 * ldb); } while (0)
#define GT_STORE(dstp) do { *(uint4*)((dstp) + so0) = ra_0; *(uint4*)((dstp) + 16384 + so0) = rb_0; *(uint4*)((dstp) + so0 + 4096) = ra_1; *(uint4*)((dstp) + 16384 + so0 + 4096) = rb_1; \
    *(uint4*)((dstp) + so0 + 8192) = ra_2; *(uint4*)((dstp) + 16384 + so0 + 8192) = rb_2; *(uint4*)((dstp) + so0 + 12288) = ra_3; *(uint4*)((dstp) + 16384 + so0 + 12288) = rb_3; } while (0)
  GT_LOAD(0);
  GT_STORE(smem);
  HSYNC();
  for (int kt = 0; kt < nk; ++kt) {
    char* cur = smem + (kt & 1) * 32768;
    char* nxt = smem + ((kt + 1) & 1) * 32768;
    if (kt + 1 < nk) { GT_LOAD(kt + 1); }
#pragma unroll
    for (int kk = 0; kk < 2; ++kk) {
      bf16x8 af[4], bfr[4];
#pragma unroll
      for (int m = 0; m < 4; ++m) {
        int r = wr * 64 + m * 16 + l15;
        af[m] = *(const bf16x8*)(cur + r * 128 + (((kk * 4 + quad) ^ (r & 7)) << 4));
      }
#pragma unroll
      for (int n = 0; n < 4; ++n) {
        int r = wc * 64 + n * 16 + l15;
        bfr[n] = *(const bf16x8*)(cur + 16384 + r * 128 + (((kk * 4 + quad) ^ (r & 7)) << 4));
      }
#pragma unroll
      for (int m = 0; m < 4; ++m)
#pragma unroll
        for (int n = 0; n < 4; ++n) acc[m][n] = __builtin_amdgcn_mfma_f32_16x16x32_bf16(af[m], bfr[n], acc[m][n], 0, 0, 0);
    }
    if (kt + 1 < nk) { GT_STORE(nxt); }
    HSYNC();
  }
#undef GT_LOAD
#undef GT_STORE
}

__device__ __forceinline__ int g2_lds_byte(int r, int c) {
  int st = (r >> 4) * 2 + (c >> 5), ob = (r & 15) * 64 + (c & 31) * 2;
  return st * 1024 + (ob ^ (((ob >> 9) & 1) << 5));
}
__device__ __forceinline__ void g2_stage_rc(int b, int& R, int& C) {
  int st = b >> 10, sb = b & 1023, swz = sb ^ (((sb >> 9) & 1) << 5);
  R = (st >> 1) * 16 + swz / 64;
  C = (st & 1) * 32 + (swz % 64) / 2;
}
template <int NKT, int LDA, int LDB>
__device__ __forceinline__ void gemm256g(const bf16* __restrict__ Ab, const bf16* __restrict__ Bb, char* shm, f32x4 (&acc)[8][4]) {
  constexpr int TILE_B = 256 * 64 * 2, STAGE_B = 2 * TILE_B, GL = 4, nt = NKT;
  const int tid = launder((int)threadIdx.x), wid = tid >> 6, lane = tid & 63, wr = wid >> 2, wc = wid & 3, fr = lane & 15, fq = lane >> 4;
  int sOffA[GL], sOffB[GL];
#pragma unroll
  for (int i = 0; i < GL; ++i) { int R, C; g2_stage_rc(wid * 1024 + i * 8192 + lane * 16, R, C); sOffA[i] = R * LDA + C; sOffB[i] = R * LDB + C; }
#define G2_STAGE(buf, kt) do { _Pragma("unroll") for (int i = 0; i < GL; ++i) { \
    __builtin_amdgcn_global_load_lds((const unsigned*)(Ab + sOffA[i] + (kt) * 64), (unsigned*)(shm + (buf) * STAGE_B + wid * 1024 + i * 8192), 16, 0, 0); \
    __builtin_amdgcn_global_load_lds((const unsigned*)(Bb + sOffB[i] + (kt) * 64), (unsigned*)(shm + (buf) * STAGE_B + TILE_B + wid * 1024 + i * 8192), 16, 0, 0); } } while (0)
#pragma unroll
  for (int m = 0; m < 8; ++m)
#pragma unroll
    for (int n = 0; n < 4; ++n) acc[m][n] = f32x4{0.f, 0.f, 0.f, 0.f};
  G2_STAGE(0, 0);
  asm volatile("s_waitcnt vmcnt(0)" ::: "memory");
  __syncthreads();
  for (int t = 0; t < nt; ++t) {
    const int cur = t & 1;
    if (t + 1 < nt) G2_STAGE(cur ^ 1, t + 1);
    const char* sa = shm + cur * STAGE_B;
    const char* sb = sa + TILE_B;
#pragma unroll
    for (int ks = 0; ks < 2; ++ks) {
      bf16x8 At[8], Bf[4];
#pragma unroll
      for (int m = 0; m < 8; ++m) At[m] = *(const bf16x8*)(sa + g2_lds_byte(wr * 128 + m * 16 + fr, ks * 32 + fq * 8));
#pragma unroll
      for (int n = 0; n < 4; ++n) Bf[n] = *(const bf16x8*)(sb + g2_lds_byte(wc * 64 + n * 16 + fr, ks * 32 + fq * 8));
#pragma unroll
      for (int m = 0; m < 8; ++m)
#pragma unroll
        for (int n = 0; n < 4; ++n) acc[m][n] = __builtin_amdgcn_mfma_f32_16x16x32_bf16(At[m], Bf[n], acc[m][n], 0, 0, 0);
      __builtin_amdgcn_sched_barrier(0);
    }
    asm volatile("s_waitcnt vmcnt(0)" ::: "memory");
    __syncthreads();
  }
#undef G2_STAGE
}
__device__ __forceinline__ void gemm256(const bf16* __restrict__ Ab, const bf16* __restrict__ Bb, char* shm, f32x4 (&acc)[8][4]) {
  gemm256g<DM / 64, DM, DM>(Ab, Bb, shm, acc);
}
__device__ __forceinline__ void gemm256_8p(const bf16* __restrict__ A, const bf16* __restrict__ Bt, char* shmc, f32x4 (&acc)[2][2][4][2]) {
  constexpr int K = DM, BK = 64, HALF = 128, HT = HALF * BK;
  bf16* shm = (bf16*)shmc;
#define SA(b,h) (shm+((b)*2+(h))*HT)
#define SB(b,h) (shm+(4+(b)*2+(h))*HT)
#define STAGE(P_,BASE,br,kt) do{long _g=(long)(br)*K+(long)(kt)*BK; \
    for(int _i=0;_i<2;++_i){int _b=tid*16+_i*8192;int _r,_c;g2_stage_rc(_b,_r,_c); \
      __builtin_amdgcn_global_load_lds((const unsigned*)(BASE+_g+(long)_r*K+_c), \
        (unsigned*)((char*)(P_)+_b),16,0,0);}}while(0)
#define LDA(dst,b,h) for(int m=0;m<4;++m)for(int k=0;k<2;++k) \
    dst[m][k]=*reinterpret_cast<const bf16x8*>((char*)SA(b,h)+g2_lds_byte(wr*64+m*16+fr,k*32+fq*8))
#define LDB(dst,b,h) for(int n=0;n<2;++n)for(int k=0;k<2;++k) \
    dst[n][k]=*reinterpret_cast<const bf16x8*>((char*)SB(b,h)+g2_lds_byte(wc*32+n*16+fr,k*32+fq*8))
#define MMA(ai,bj,At_,Bt_) do{__builtin_amdgcn_s_setprio(1); \
    for(int m=0;m<4;++m)for(int n=0;n<2;++n)for(int k=0;k<2;++k) \
      acc[ai][bj][m][n]=__builtin_amdgcn_mfma_f32_16x16x32_bf16(At_[m][k],Bt_[n][k],acc[ai][bj][m][n],0,0,0); \
    __builtin_amdgcn_s_setprio(0);}while(0)
#define WAIT_V(n) asm volatile("s_waitcnt vmcnt(" #n ")":::"memory")
#define WAIT_L(n) asm volatile("s_waitcnt lgkmcnt(" #n ")":::"memory")
#define BAR __builtin_amdgcn_s_barrier()
#define SCHED __builtin_amdgcn_sched_barrier(0)
  const int tid = launder((int)threadIdx.x);
  const int wid = tid >> 6, lane = tid & 63, wr = wid >> 2, wc = wid & 3, fr = lane & 15, fq = lane >> 4;
#pragma unroll
  for (int a = 0; a < 2; ++a)
#pragma unroll
    for (int b = 0; b < 2; ++b)
#pragma unroll
      for (int m = 0; m < 4; ++m)
#pragma unroll
        for (int n = 0; n < 2; ++n) acc[a][b][m][n] = f32x4{0.f, 0.f, 0.f, 0.f};
  bf16x8 At[4][2], B0[2][2], B1[2][2];
  constexpr int nt = K / BK;
  STAGE(SB(0,0),Bt,0,0); STAGE(SA(0,0),A,0,0);
  STAGE(SB(0,1),Bt,HALF,0); STAGE(SA(0,1),A,HALF,0);
  if(wr==1)BAR;
  WAIT_V(4); BAR;
  STAGE(SB(1,0),Bt,0,1); STAGE(SA(1,0),A,0,1); STAGE(SB(1,1),Bt,HALF,1);
  WAIT_V(6); BAR;
  for(int t=0;t<nt-2;t+=2){
    LDB(B0,0,0); SCHED; LDA(At,0,0); STAGE(SA(1,1),A,HALF,t+1);
    WAIT_L(8); BAR; WAIT_L(0); MMA(0,0,At,B0); BAR; SCHED;
    LDB(B1,0,1); STAGE(SB(0,0),Bt,0,t+2);
    BAR; WAIT_L(0); MMA(0,1,At,B1); BAR;
    LDA(At,0,1); STAGE(SA(0,0),A,0,t+2);
    BAR; WAIT_L(0); MMA(1,0,At,B0); BAR; SCHED;
    STAGE(SB(0,1),Bt,HALF,t+2);
    WAIT_V(6); BAR; MMA(1,1,At,B1); BAR;
    LDB(B0,1,0); SCHED; LDA(At,1,0); STAGE(SA(0,1),A,HALF,t+2);
    WAIT_L(8); BAR; WAIT_L(0); MMA(0,0,At,B0); BAR; SCHED;
    LDB(B1,1,1); STAGE(SB(1,0),Bt,0,t+3);
    BAR; WAIT_L(0); MMA(0,1,At,B1); BAR;
    LDA(At,1,1); STAGE(SA(1,0),A,0,t+3);
    BAR; WAIT_L(0); MMA(1,0,At,B0); BAR; SCHED;
    STAGE(SB(1,1),Bt,HALF,t+3);
    WAIT_V(6); BAR; MMA(1,1,At,B1); BAR;
  }
  { LDB(B0,0,0); LDA(At,0,0); STAGE(SA(1,1),A,HALF,nt-1);
    BAR; WAIT_L(0); MMA(0,0,At,B0); BAR;
    LDB(B1,0,1); BAR; WAIT_L(0); MMA(0,1,At,B1); BAR;
    LDA(At,0,1); WAIT_V(4); BAR; WAIT_L(0); MMA(1,0,At,B0); MMA(1,1,At,B1); BAR; }
  { LDB(B0,1,0); LDA(At,1,0); WAIT_V(2); BAR; WAIT_L(0); MMA(0,0,At,B0); BAR;
    LDB(B1,1,1); WAIT_V(0); BAR; WAIT_L(0); MMA(0,1,At,B1); BAR;
    LDA(At,1,1); BAR; WAIT_L(0); MMA(1,0,At,B0); MMA(1,1,At,B1); BAR; }
  if(wr==0)BAR;
#undef SA
#undef SB
#undef STAGE
#undef LDA
#undef LDB
#undef MMA
#undef WAIT_V
#undef WAIT_L
#undef BAR
#undef SCHED
}

__device__ __forceinline__ void g2_tile(int L, int nM, int nN, int& pm, int& pn) {
  const int nwg = nM * nN;
  int wgid = L;
  { const int q = nwg / 8, r = nwg % 8, xcd = wgid % 8, off = wgid / 8; wgid = (xcd < r ? xcd * (q + 1) : r * (q + 1) + (xcd - r) * q) + off; }
  const int nig = 8 * nN, gid = wgid / nig, fm = gid * 8, gsz = (nM - fm) < 8 ? (nM - fm) : 8;
  pm = fm + ((wgid % nig) % gsz); pn = (wgid % nig) / gsz;
}

__device__ void transpose_tile(const float* __restrict__ src, int ldsrc, int k0, int srccol0, bf16* __restrict__ dst, int lddst, int dstrow0,
                               const float* __restrict__ gk, bool zero, char* smem) {
  float* tl = (float*)smem;
  const int tid = launder((int)threadIdx.x & 255);
  {
    const int kq = tid >> 6, nn = tid & 63;
    float v[16], g[16];
    const float* sp = src + (size_t)(k0 + kq) * ldsrc + srccol0 + nn;
#pragma unroll
    for (int i = 0; i < 16; ++i) v[i] = zero ? 0.f : sp[(size_t)(4 * i) * ldsrc];
#pragma unroll
    for (int i = 0; i < 16; ++i) g[i] = gk ? gk[k0 + kq + 4 * i] : 1.f;
#pragma unroll
    for (int i = 0; i < 16; ++i) tl[(kq + 4 * i) * 65 + nn] = v[i] * g[i];
  }
  HSYNC();
#pragma unroll
  for (int i = 0; i < 2; ++i) {
    int id = tid + 256 * i, nn = id >> 3, kc = id & 7;
    uint4 o;
    o.x = pack2(tl[(kc * 8 + 0) * 65 + nn], tl[(kc * 8 + 1) * 65 + nn]);
    o.y = pack2(tl[(kc * 8 + 2) * 65 + nn], tl[(kc * 8 + 3) * 65 + nn]);
    o.z = pack2(tl[(kc * 8 + 4) * 65 + nn], tl[(kc * 8 + 5) * 65 + nn]);
    o.w = pack2(tl[(kc * 8 + 6) * 65 + nn], tl[(kc * 8 + 7) * 65 + nn]);
    *(uint4*)(dst + (size_t)(dstrow0 + nn) * lddst + k0 + kc * 8) = o;
  }
  HSYNC();
}
__device__ void win_transpose_task(const Params& P, int l, int task, char* smem) {
  int nt = task >> 5, kt = task & 31;
  int n0 = nt * 64;
  int srccol; bool zero = false;
  if (n0 < 1856) srccol = n0;
  else if (n0 < 2880) srccol = 4928 + (n0 - 1856);
  else if (n0 < 2944 || n0 >= 6016) { srccol = 0; zero = true; }
  else srccol = 1856 + (n0 - 2944);
  transpose_tile(P.w_in + (size_t)l * DM * NIN, NIN, kt * 64, srccol, P.wT_in, DM, n0, nullptr, zero, smem);
}
__device__ void modulation_task(const Params& P, int task, char* smem) {
  float* s = (float*)smem;
  float* red = s + 5 * 2048;
  const int tid = launder((int)threadIdx.x & 255);
  int l = task / 96, cgp = task % 96;
  for (int i = tid; i < 5 * 2048; i += 256) {
    int v = i >> 11, k = i & 2047;
    float cv = (v < 4) ? P.c[v * 2048 + k] : P.c_ctx[k];
    s[i] = cv / (1.f + expf(-cv));
  }
  HSYNC();
  int kg = tid >> 6, cj = tid & 63, col = cgp * 64 + cj;
  float acc[5] = {0.f, 0.f, 0.f, 0.f, 0.f};
  const float* wp = P.ada_w + ((size_t)l * 2048 + kg * 512) * 6144 + col;
  const float* sp = s + kg * 512;
#pragma unroll 8
  for (int k = 0; k < 512; ++k) {
    float wv = wp[(size_t)k * 6144];
#pragma unroll
    for (int v = 0; v < 5; ++v) acc[v] += sp[v * 2048 + k] * wv;
  }
#pragma unroll
  for (int v = 0; v < 5; ++v) red[(kg * 5 + v) * 64 + cj] = acc[v];
  HSYNC();
  for (int i = tid; i < 320; i += 256) {
    int v = i >> 6, c2 = i & 63;
    float a = red[(0 * 5 + v) * 64 + c2] + red[(1 * 5 + v) * 64 + c2] + red[(2 * 5 + v) * 64 + c2] + red[(3 * 5 + v) * 64 + c2];
    int cc = cgp * 64 + c2;
    P.mod[(size_t)(l * 5 + v) * 6144 + cc] = a + P.ada_b[l * 6144 + cc];
  }
  HSYNC();
}
__device__ void h2_task(const Params& P, int task, char* smem) {
  float* zf = (float*)smem;
  float* h1 = zf + 4 * 36;
  const int tid = launder((int)threadIdx.x & 255), pos = tid >> 6, j = tid & 63;
  int which, n0;
  if (task < 1024) { which = 0; n0 = task * 4; }
  else if (task < 2048) { which = 1; n0 = (task - 1024) * 4; }
  else { which = 2; n0 = (task - 2048) * 4; }
  const int Lc = (which == 2) ? 256 : 4096;
  const int l = (which == 1) ? 1 : 0;
  const int n = n0 + pos;
  if (j < 33) {
    float v;
    if (j == 0) v = (float)n / (float)(Lc - 1);
    else {
      int k = (j - 1) & 15;
      float f = 1e-4f + (float)k * ((15.f - 1e-4f) / 15.f);
      float wpos = (6.283185307179586f * (float)n) / (float)Lc;
      float a = f * wpos;
      v = (j <= 16) ? cosf(a) : -sinf(a);
    }
    zf[pos * 36 + j] = v;
  }
  HSYNC();
  float fr = P.filt_freq[l * 64 + j];
  float a = P.filt_b1[l * 64 + j];
#pragma unroll
  for (int i = 0; i < 33; ++i) a += zf[pos * 36 + i] * P.filt_w1[(l * 33 + i) * 64 + j];
  h1[pos * 64 + j] = sinf(fr * a);
  HSYNC();
  float a2 = P.filt_b2[l * 64 + j];
#pragma unroll 8
  for (int i = 0; i < 64; ++i) a2 += h1[pos * 64 + i] * P.filt_w2[(l * 64 + i) * 64 + j];
  float hv = sinf(fr * a2);
  if (which == 2) P.h2cT[j * 256 + n] = hv;
  else P.h2T[((size_t)l * 64 + j) * 4096 + n] = f2bf(hv);
  HSYNC();
}
__device__ void rope_table_task(const Params& P) {
  for (int i = launder((int)threadIdx.x & 255); i < 64 * 16; i += 256) {
    int pos = i >> 4, f = i & 15;
    float inv = powf(10000.f, -(float)f / 16.f);
    float ang = (float)pos * inv;
    P.rope[2 * i] = cosf(ang);
    P.rope[2 * i + 1] = sinf(ang);
  }
}

__device__ __forceinline__ void prenorm_store(const Params& P, const float4* v, int row, int l, int mv, int lane) {
  float ss = 0.f;
#pragma unroll
  for (int i = 0; i < 8; ++i) ss += v[i].x * v[i].x + v[i].y * v[i].y + v[i].z * v[i].z + v[i].w * v[i].w;
  ss = wave_sum(ss);
  float r = rsqrtf(ss * (1.f / 2048.f) + EPSN);
  const float* md = P.mod + (size_t)(l * 5 + mv) * 6144;
#pragma unroll
  for (int i = 0; i < 8; ++i) {
    int idx = (i * 64 + lane) * 4;
    float4 g = *(const float4*)(P.pre_g + l * 2048 + idx);
    float4 sh = *(const float4*)(md + idx);
    float4 sc = *(const float4*)(md + 2048 + idx);
    float o0 = v[i].x * r * g.x * (1.f + sc.x) + sh.x;
    float o1 = v[i].y * r * g.y * (1.f + sc.y) + sh.y;
    float o2 = v[i].z * r * g.z * (1.f + sc.z) + sh.z;
    float o3 = v[i].w * r * g.w * (1.f + sc.w) + sh.w;
    uint2 o; o.x = pack2(o0, o1); o.y = pack2(o2, o3);
    *(uint2*)(P.xh + (size_t)row * 2048 + idx) = o;
  }
}
__device__ void phase_prenorm0(const Params& P) {
  const int lane = launder((int)threadIdx.x & 255) & 63, wv = launder((int)threadIdx.x & 255) >> 6;
  for (int row = VBID * 4 + wv; row < TT; row += VGRID * 4) {
    const float* src = (row < TX) ? (P.x + (size_t)row * 2048) : (P.ctx + (size_t)(row - TX) * 2048);
    int mv = (row < TX) ? (row >> 12) : 4;
    float4 v[8];
#pragma unroll
    for (int i = 0; i < 8; ++i) v[i] = *(const float4*)(src + (i * 64 + lane) * 4);
    prenorm_store(P, v, row, 0, mv, lane);
  }
}
__device__ void phase_post(const Params& P, int l) {
  const int lane = launder((int)threadIdx.x & 255) & 63, wv = launder((int)threadIdx.x & 255) >> 6;
  const int nrows = (l == 0) ? TT : TX;
  for (int row = VBID * 4 + wv; row < nrows; row += VGRID * 4) {
    const bool isx = row < TX;
    int mv = isx ? (row >> 12) : 4;
    const float* zr = P.z + (size_t)row * 2048;
    const float* xo = (l == 0) ? (isx ? P.x + (size_t)row * 2048 : P.ctx + (size_t)(row - TX) * 2048) : (P.out + (size_t)row * 2048);
    float* xn = isx ? (P.out + (size_t)row * 2048) : (P.ctx1 + (size_t)(row - TX) * 2048);
    float4 zv[8];
    float ss = 0.f;
#pragma unroll
    for (int i = 0; i < 8; ++i) {
      zv[i] = *(const float4*)(zr + (i * 64 + lane) * 4);
      ss += zv[i].x * zv[i].x + zv[i].y * zv[i].y + zv[i].z * zv[i].z + zv[i].w * zv[i].w;
    }
    ss = wave_sum(ss);
    float r = rsqrtf(ss * (1.f / 2048.f) + EPSN);
    const float* gt = P.mod + (size_t)(l * 5 + mv) * 6144 + 4096;
#pragma unroll
    for (int i = 0; i < 8; ++i) {
      int idx = (i * 64 + lane) * 4;
      float4 xv = *(const float4*)(xo + idx);
      float4 g = *(const float4*)(gt + idx);
      float4 pg = *(const float4*)(P.post_g + l * 2048 + idx);
      zv[i].x = xv.x + g.x * zv[i].x * r * pg.x;
      zv[i].y = xv.y + g.y * zv[i].y * r * pg.y;
      zv[i].z = xv.z + g.z * zv[i].z * r * pg.z;
      zv[i].w = xv.w + g.w * zv[i].w * r * pg.w;
      *(float4*)(xn + idx) = zv[i];
    }
    if (l == 0) prenorm_store(P, zv, row, 1, mv, lane);
  }
  if (l == 0) {
  }
}

__device__ void gemm_in_task(const Params& P, int l, int mt, int nt, char* smem) {
  f32x4 acc[2][2][4][2];
  const int row0 = mt * 256, col0 = nt * 256;
  gemm256_8p(P.xh + (size_t)row0 * DM, P.wT_in + (size_t)col0 * DM, smem, acc);
  const int tid = launder((int)threadIdx.x), lane = tid & 63, w = tid >> 6, wr = w >> 2, wc = w & 3, l15 = lane & 15, quad = lane >> 4;
  const bool isx = row0 < TX;
#pragma unroll
  for (int ai = 0; ai < 2; ++ai)
#pragma unroll
    for (int bj = 0; bj < 2; ++bj) {
      const int rowb = row0 + ai * 128 + wr * 64;
      const int colc = col0 + bj * 128 + wc * 32;
      if (colc < NPA) {
        if (colc >= 768 && colc < 832) {
          const int axis = (colc - 768) >> 5;
#pragma unroll
          for (int m = 0; m < 4; ++m)
#pragma unroll
            for (int j = 0; j < 4; ++j) {
              int row = rowb + m * 16 + quad * 4 + j;
              float v0 = acc[ai][bj][m][0][j], v1 = acc[ai][bj][m][1][j];
              int b, kk;
              if (isx) {
                int t = row & 4095; b = row >> 12; kk = 256 + t;
                int pos = axis ? (t & 63) : (t >> 6);
                float2 cs = *(const float2*)(P.rope + 2 * (pos * 16 + l15));
                float a0 = v0 * cs.x - v1 * cs.y, a1 = v1 * cs.x + v0 * cs.y;
                v0 = a0; v1 = a1;
              } else { int rc = row - TX; b = rc >> 8; kk = rc & 255; }
              bf16* dst = P.kr + ((size_t)b * LK + kk) * 64 + axis * 32 + l15;
              dst[0] = f2bf(v0); dst[16] = f2bf(v1);
            }
        } else {
#pragma unroll
          for (int m = 0; m < 4; ++m)
#pragma unroll
            for (int n = 0; n < 2; ++n)
#pragma unroll
              for (int j = 0; j < 4; ++j) {
                int row = rowb + m * 16 + quad * 4 + j, col = colc + n * 16 + l15;
                P.pa[(size_t)row * NPA + col] = f2bf(acc[ai][bj][m][n][j]);
              }
        }
      } else if (colc < NPA + NHYC) {
        const int hc0 = colc - NPA;
        if (isx) {
          const int b = row0 >> 12, t0 = (rowb & 4095);
#pragma unroll
          for (int m = 0; m < 4; ++m)
#pragma unroll
            for (int n = 0; n < 2; ++n) {
              int hc = hc0 + n * 16 + l15, t = t0 + m * 16 + quad * 4;
              uint2 o; o.x = pack2(acc[ai][bj][m][n][0], acc[ai][bj][m][n][1]); o.y = pack2(acc[ai][bj][m][n][2], acc[ai][bj][m][n][3]);
              *(uint2*)(P.pT + ((size_t)b * NHYC + hc) * 4096 + t) = o;
            }
        } else if (l == 0) {
#pragma unroll
          for (int m = 0; m < 4; ++m)
#pragma unroll
            for (int n = 0; n < 2; ++n)
#pragma unroll
              for (int j = 0; j < 4; ++j) {
                int row = rowb + m * 16 + quad * 4 + j - TX, hc = hc0 + n * 16 + l15;
                P.pchy[(size_t)row * NHYC + hc] = f2bf(acc[ai][bj][m][n][j]);
              }
        }
      }
    }
  __syncthreads();
}
__device__ void phase_gemm_in(const Params& P, int l, char* smem) {
  const int nM = 68, nN = 24;
  for (int L = blockIdx.x; L < nM * nN; L += gridDim.x) {
    int mt, nt;
    g2_tile(L, nM, nN, mt, nt);
    if (l == 1 && mt >= 64 && nt >= 12) continue;
    gemm_in_task(P, l, mt, nt, smem);
  }
}

__device__ void q_gemm_task(const Params& P, int l, int mt, int nt, char* smem) {
  float* rs = (float*)(smem + 131072);
  const int tid = launder((int)threadIdx.x), lane = tid & 63, w = tid >> 6, wr = w >> 2, wc = w & 3, l15 = lane & 15, quad = lane >> 4;
  const int row0 = mt * 256, col0 = nt * 256;
#pragma unroll 1
  for (int g = 0; g < 2; ++g) {
    uint4 v[16];
    const bf16* pb = P.pa + (size_t)(row0 + w * 32 + g * 16) * NPA + lane * 8;
#pragma unroll
    for (int e = 0; e < 16; ++e) v[e] = *(const uint4*)(pb + (size_t)e * NPA);
    float ss[16];
#pragma unroll
    for (int e = 0; e < 16; ++e) {
      unsigned uu[4] = {v[e].x, v[e].y, v[e].z, v[e].w};
      float a = 0.f;
#pragma unroll
      for (int q = 0; q < 4; ++q) { float x0 = __uint_as_float(uu[q] << 16), x1 = __uint_as_float(uu[q] & 0xffff0000u); a += x0 * x0 + x1 * x1; }
      ss[e] = a;
    }
#pragma unroll
    for (int e = 0; e < 16; ++e) { float t2 = wave_sum(ss[e]); if (lane == 0) rs[w * 32 + g * 16 + e] = rsqrtf(t2 * (1.f / 512.f) + EPSN) * QSCALE; }
  }
  __syncthreads();
  f32x4 acc[8][4];
  gemm256g<8, NPA, 512>(P.pa + (size_t)row0 * NPA, P.wT_uq + (size_t)l * QW * 512 + (size_t)col0 * 512, smem, acc);
  const int rowbase = row0 + wr * 128, colbase = col0 + wc * 64;
  const bool isx = row0 < TX;
  const bool ropet = isx && (((colbase >> 6) % 3) == 2);
#pragma unroll
  for (int m = 0; m < 8; ++m)
#pragma unroll
    for (int j = 0; j < 4; ++j) {
      int row = rowbase + m * 16 + quad * 4 + j;
      float sc = rs[row - row0];
      float v0 = acc[m][0][j] * sc, v1 = acc[m][1][j] * sc, v2 = acc[m][2][j] * sc, v3 = acc[m][3][j] * sc;
      if (ropet) {
        int t = row & 4095;
        float2 cs0 = *(const float2*)(P.rope + 2 * ((t >> 6) * 16 + l15));
        float2 cs1 = *(const float2*)(P.rope + 2 * ((t & 63) * 16 + l15));
        float a0 = v0 * cs0.x - v1 * cs0.y, a1 = v1 * cs0.x + v0 * cs0.y;
        float a2 = v2 * cs1.x - v3 * cs1.y, a3 = v3 * cs1.x + v2 * cs1.y;
        v0 = a0; v1 = a1; v2 = a2; v3 = a3;
      }
      bf16* dst = P.qbuf + (size_t)row * QW + colbase + l15;
      dst[0] = f2bf(v0); dst[16] = f2bf(v1); dst[32] = f2bf(v2); dst[48] = f2bf(v3);
    }
  __syncthreads();
}
__device__ void kv_gemm_task(const Params& P, int l, int mt, int h, char* smem) {
  float* rs = (float*)(smem + 131072);
  const int tid = launder((int)threadIdx.x), lane = tid & 63, w = tid >> 6, wr = w >> 2, wc = w & 3, l15 = lane & 15, quad = lane >> 4;
  const int row0 = mt * 256;
#pragma unroll 1
  for (int g = 0; g < 2; ++g) {
    uint2 v[16];
    const bf16* pb = P.pa + (size_t)(row0 + w * 32 + g * 16) * NPA + 512 + lane * 4;
#pragma unroll
    for (int e = 0; e < 16; ++e) v[e] = *(const uint2*)(pb + (size_t)e * NPA);
    float ss[16];
#pragma unroll
    for (int e = 0; e < 16; ++e) {
      float a0 = __uint_as_float(v[e].x << 16), a1 = __uint_as_float(v[e].x & 0xffff0000u), a2 = __uint_as_float(v[e].y << 16), a3 = __uint_as_float(v[e].y & 0xffff0000u);
      ss[e] = a0 * a0 + a1 * a1 + a2 * a2 + a3 * a3;
    }
#pragma unroll
    for (int e = 0; e < 16; ++e) { float t2 = wave_sum(ss[e]); if (lane == 0) rs[w * 32 + g * 16 + e] = rsqrtf(t2 * (1.f / 256.f) + EPSN); }
  }
  __syncthreads();
  f32x4 acc[8][4];
  gemm256g<4, NPA, 256>(P.pa + (size_t)row0 * NPA + 512, P.wT_ukv + (size_t)l * 2048 * 256 + (size_t)h * 256 * 256, smem, acc);
  const int rowbase = row0 + wr * 128;
  int b, kk0;
  if (row0 < TX) { b = row0 >> 12; kk0 = 256 + (rowbase & 4095); }
  else { int rc = rowbase - TX; b = rc >> 8; kk0 = rc & 255; }
  if (wc < 2) {
#pragma unroll
    for (int m = 0; m < 8; ++m)
#pragma unroll
      for (int j = 0; j < 4; ++j) {
        int rl = m * 16 + quad * 4 + j;
        float sc = rs[wr * 128 + rl];
        bf16* dst = P.Kn + (((size_t)b * 8 + h) * LK + kk0 + rl) * 128 + wc * 64 + l15;
#pragma unroll
        for (int n = 0; n < 4; ++n) dst[n * 16] = f2bf(acc[m][n][j] * sc);
      }
  } else {
#pragma unroll
    for (int m = 0; m < 8; ++m) {
      int rl = m * 16 + quad * 4;
      float s0 = rs[wr * 128 + rl], s1 = rs[wr * 128 + rl + 1], s2 = rs[wr * 128 + rl + 2], s3 = rs[wr * 128 + rl + 3];
#pragma unroll
      for (int n = 0; n < 4; ++n) {
        int d = (wc - 2) * 64 + n * 16 + l15;
        uint2 o; o.x = pack2(acc[m][n][0] * s0, acc[m][n][1] * s1); o.y = pack2(acc[m][n][2] * s2, acc[m][n][3] * s3);
        *(uint2*)(P.vT + (((size_t)b * 8 + h) * 128 + d) * LK + kk0 + rl) = o;
      }
    }
  }
  __syncthreads();
}

__device__ __forceinline__ float conv3(const bf16* __restrict__ rowp, int n, float w0, float w1, float w2, float bb) {
  float a = bb + w1 * bf2f(rowp[n]);
  if (n > 0) a += w0 * bf2f(rowp[n - 1]);
  if (n < 4095) a += w2 * bf2f(rowp[n + 1]);
  return a;
}
__device__ __forceinline__ float convl(const bf16* rowp, int n, float w0, float w1, float w2, float bb) {
  float pm = bf2f(rowp[n > 0 ? n - 1 : 0]), pc = bf2f(rowp[n]), pp = bf2f(rowp[n < 4095 ? n + 1 : 4095]);
  return bb + w1 * pc + ((n > 0) ? w0 : 0.f) * pm + ((n < 4095) ? w2 : 0.f) * pp;
}
__device__ void hyena_x_task(const Params& P, int l, int c, char* smem) {
  cf* lds = (cf*)smem;
  cf* est = (cf*)(smem + 34816);
  float* hbx = (float*)(smem + 34816);
  float* w3s = (float*)(smem + 34816 + 32768);
  const int t = launder((int)threadIdx.x & 255);
  FftTw tw;
  tw.c1 = cispi(-(float)t / 2048.f);
  tw.c2 = cispi(-(float)(t & 15) / 128.f);
  tw.c4 = cispi(-(float)((t & 15) * (t >> 4)) / 2048.f);
  tw.c5 = cispi(-(float)(t >> 4) / 128.f);
  const cf c8 = cispi(-(float)t / 4096.f);
  const cf w32 = cf{0.98078528040323043f, -0.19509032201612825f};
  if (t < 128) w3s[t] = P.filt_w3[((size_t)l * 64 + (t & 63)) * 2048 + (t >> 6) * 1024 + c];
  __syncthreads();
  cf* kfe = (cf*)P.kfg + (size_t)VBID * 8192;
  cf* kfo = kfe + 4096;
  {
    cf ke[16];
    float af[16], ab[16];
    float* hfx = (float*)(smem + 34816);
    float* hbx2 = (float*)(smem + 34816 + 16384);
    {
#pragma unroll
      for (int j = 0; j < 16; ++j) { af[j] = 0.f; ab[j] = 0.f; }
      const bf16* h2p = P.h2T + (size_t)l * 64 * 4096;
#pragma unroll 2
      for (int i = 0; i < 64; ++i) {
        const float wf = w3s[i], wb = w3s[64 + i];
        const uint4* hp = (const uint4*)(h2p + i * 4096 + 16 * t);
        const uint4 q0 = hp[0], q1 = hp[1];
        float4 h0, h1, h2v, h3;
        h0.x = __uint_as_float(q0.x << 16); h0.y = __uint_as_float(q0.x & 0xffff0000u); h0.z = __uint_as_float(q0.y << 16); h0.w = __uint_as_float(q0.y & 0xffff0000u);
        h1.x = __uint_as_float(q0.z << 16); h1.y = __uint_as_float(q0.z & 0xffff0000u); h1.z = __uint_as_float(q0.w << 16); h1.w = __uint_as_float(q0.w & 0xffff0000u);
        h2v.x = __uint_as_float(q1.x << 16); h2v.y = __uint_as_float(q1.x & 0xffff0000u); h2v.z = __uint_as_float(q1.y << 16); h2v.w = __uint_as_float(q1.y & 0xffff0000u);
        h3.x = __uint_as_float(q1.z << 16); h3.y = __uint_as_float(q1.z & 0xffff0000u); h3.z = __uint_as_float(q1.w << 16); h3.w = __uint_as_float(q1.w & 0xffff0000u);
        af[0] += h0.x * wf; af[1] += h0.y * wf; af[2] += h0.z * wf; af[3] += h0.w * wf;
        af[4] += h1.x * wf; af[5] += h1.y * wf; af[6] += h1.z * wf; af[7] += h1.w * wf;
        af[8] += h2v.x * wf; af[9] += h2v.y * wf; af[10] += h2v.z * wf; af[11] += h2v.w * wf;
        af[12] += h3.x * wf; af[13] += h3.y * wf; af[14] += h3.z * wf; af[15] += h3.w * wf;
        ab[0] += h0.x * wb; ab[1] += h0.y * wb; ab[2] += h0.z * wb; ab[3] += h0.w * wb;
        ab[4] += h1.x * wb; ab[5] += h1.y * wb; ab[6] += h1.z * wb; ab[7] += h1.w * wb;
        ab[8] += h2v.x * wb; ab[9] += h2v.y * wb; ab[10] += h2v.z * wb; ab[11] += h2v.w * wb;
        ab[12] += h3.x * wb; ab[13] += h3.y * wb; ab[14] += h3.z * wb; ab[15] += h3.w * wb;
      }
      const float d0 = -15.350567286626973f, d1 = -3.0701134573253946f;
      const float adel = fabsf(d0 + (float)c * ((d1 - d0) / 1023.f));
#pragma unroll
      for (int j = 0; j < 16; ++j) {
        int n = 16 * t + j;
        float dec = expf(-((float)n * (1.f / 4095.f)) * adel);
        hfx[n] = af[j] * dec; hbx2[n] = ab[j] * dec;
      }
    }
    __syncthreads();
#pragma unroll
    for (int j = 0; j < 16; ++j) {
      int n = 256 * j + t;
      float k0 = hfx[n];
      float k1 = (n == 0) ? 0.f : hbx2[4096 - n];
      ke[j] = cf{k0 + k1, 0.f};
      af[j] = k0 - k1;
    }
    __syncthreads();
    fft_fwd(ke, t, tw, lds);
    { const int tl = launder(t); _Pragma("unroll") for (int r = 0; r < 16; ++r) kfe[r * 256 + tl] = ke[r]; }
    cf wn = cf{launderf(c8.x), launderf(c8.y)};
#pragma unroll
    for (int j = 0; j < 16; ++j) { ke[j] = cf{af[j] * wn.x, af[j] * wn.y}; wn = cmul(wn, w32); }
    fft_fwd(ke, t, tw, lds);
    { const int tl = launder(t); _Pragma("unroll") for (int r = 0; r < 16; ++r) kfo[r * 256 + tl] = ke[r]; }
  }
  const float cw10 = P.conv_w[(l * 3 + 0) * 3072 + 1024 + c], cw11 = P.conv_w[(l * 3 + 1) * 3072 + 1024 + c], cw12 = P.conv_w[(l * 3 + 2) * 3072 + 1024 + c];
  const float cwv0 = P.conv_w[(l * 3 + 0) * 3072 + 2048 + c], cwv1 = P.conv_w[(l * 3 + 1) * 3072 + 2048 + c], cwv2 = P.conv_w[(l * 3 + 2) * 3072 + 2048 + c];
  const float cw00 = P.conv_w[(l * 3 + 0) * 3072 + c], cw01 = P.conv_w[(l * 3 + 1) * 3072 + c], cw02 = P.conv_w[(l * 3 + 2) * 3072 + c];
  const float cb0 = P.conv_b[l * 3072 + c], cb1 = P.conv_b[l * 3072 + 1024 + c], cbv = P.conv_b[l * 3072 + 2048 + c];
  const float Dc = P.hy_D[l * 1024 + c];
  for (int pr = 0; pr < 2; ++pr) {
    const int b0 = 2 * pr, b1 = 2 * pr + 1;
    bf16* rows = (bf16*)(smem + 34816);
    {
      const int tl = launder(t);
#pragma unroll
      for (int q = 0; q < 8; ++q) {
        const int rr = q >> 1, ch = tl + 256 * (q & 1);
        const int bb = (rr >> 1) ? b1 : b0, grp = (rr & 1) ? 2048 : 1024;
        uint4 v = *(const uint4*)(P.pT + ((size_t)bb * NHYC + grp + c) * 4096 + ch * 8);
        *(uint4*)(rows + rr * 4096 + ch * 8) = v;
      }
    }
    __syncthreads();
    cf u[16], x[16];
#pragma unroll 4
    for (int j = 0; j < 16; ++j) {
      int n = 256 * j + t;
      float ua = convl(rows, n, cw10, cw11, cw12, cb1) * convl(rows + 4096, n, cwv0, cwv1, cwv2, cbv);
      float ub = convl(rows + 8192, n, cw10, cw11, cw12, cb1) * convl(rows + 12288, n, cwv0, cwv1, cwv2, cbv);
      lds[(t + (t >> 4)) + 272 * j] = cf{ua, ub};
    }
#pragma unroll
    for (int j = 0; j < 16; ++j) { u[j] = lds[(t + (t >> 4)) + 272 * j]; x[j] = u[j]; }
    __syncthreads();
    fft_fwd(x, t, tw, lds);
    { const int tl = launder(t); _Pragma("unroll") for (int r = 0; r < 16; ++r) x[r] = cmul(x[r], kfe[r * 256 + tl]); }
    fft_inv(x, t, tw, lds);
#pragma unroll
    for (int j = 0; j < 16; ++j) est[256 * j + t] = x[j];
    {
      cf wn = cf{launderf(c8.x), launderf(c8.y)};
#pragma unroll
      for (int j = 0; j < 16; ++j) { x[j] = cmul(u[j], wn); wn = cmul(wn, w32); }
    }
    fft_fwd(x, t, tw, lds);
    { const int tl = launder(t); _Pragma("unroll") for (int r = 0; r < 16; ++r) x[r] = cmul(x[r], kfo[r * 256 + tl]); }
    fft_inv(x, t, tw, lds);
    {
      cf wn = cf{launderf(c8.x), launderf(c8.y)};
#pragma unroll
      for (int j = 0; j < 16; ++j) {
        cf o = cmulc(x[j], wn);
        cf e = est[256 * j + t];
        est[256 * j + t] = cf{(e.x + o.x) * (1.f / 8192.f) + Dc * u[j].x, (e.y + o.y) * (1.f / 8192.f) + Dc * u[j].y};
        wn = cmul(wn, w32);
      }
    }
    bf16* r0 = (bf16*)smem;
    {
      const int tl = launder(t);
#pragma unroll
      for (int q = 0; q < 4; ++q) {
        const int rr = q >> 1, ch = tl + 256 * (q & 1);
        const int bb = rr ? b1 : b0;
        uint4 v = *(const uint4*)(P.pT + ((size_t)bb * NHYC + c) * 4096 + ch * 8);
        *(uint4*)(r0 + rr * 4096 + ch * 8) = v;
      }
    }
    __syncthreads();
    bf16* oa = P.yhT + ((size_t)b0 * 1024 + c) * 4096;
    bf16* ob = P.yhT + ((size_t)b1 * 1024 + c) * 4096;
#pragma unroll 4
    for (int j = 0; j < 16; ++j) {
      int n = 256 * j + t;
      cf yv = est[n];
      float xa = convl(r0, n, cw00, cw01, cw02, cb0), xb = convl(r0 + 4096, n, cw00, cw01, cw02, cb0);
      oa[n] = f2bf(xa * yv.x);
      ob[n] = f2bf(xb * yv.y);
    }
    __syncthreads();
  }
}
__device__ void hyena_ctx_task(const Params& P, int c, char* smem) {
  float* hf = (float*)smem;
  float* hb = hf + 256;
  float* us = hb + 256;
  const int t = launder((int)threadIdx.x & 255);
  const int l = 0;
  float af = 0.f, ab = 0.f;
  float* w3c = us + 4 * 256;
  if (t < 128) w3c[t] = P.filt_w3[((size_t)l * 64 + (t & 63)) * 2048 + (t >> 6) * 1024 + c];
  __syncthreads();
#pragma unroll 16
  for (int i = 0; i < 64; ++i) {
    float hv = P.h2cT[i * 256 + t];
    af += hv * w3c[i];
    ab += hv * w3c[64 + i];
  }
  const float d0 = -15.350567286626973f, d1 = -3.0701134573253946f;
  const float adel = fabsf(d0 + (float)c * ((d1 - d0) / 1023.f));
  float dec = expf(-((float)t / 255.f) * adel);
  hf[t] = af * dec; hb[t] = ab * dec;
  float x0c[4], uu[4];
#pragma unroll
  for (int b = 0; b < 4; ++b) {
    const bf16* base = P.pchy + (size_t)(b * 256) * NHYC;
    float cv[3];
#pragma unroll
    for (int g = 0; g < 3; ++g) {
      int col = g * 1024 + c;
      float a = P.conv_b[l * 3072 + col] + P.conv_w[(l * 3 + 1) * 3072 + col] * bf2f(base[(size_t)t * NHYC + col]);
      if (t > 0) a += P.conv_w[(l * 3 + 0) * 3072 + col] * bf2f(base[(size_t)(t - 1) * NHYC + col]);
      if (t < 255) a += P.conv_w[(l * 3 + 2) * 3072 + col] * bf2f(base[(size_t)(t + 1) * NHYC + col]);
      cv[g] = a;
    }
    x0c[b] = cv[0]; uu[b] = cv[1] * cv[2];
    us[b * 256 + t] = uu[b];
  }
  __syncthreads();
  float acc[4] = {0.f, 0.f, 0.f, 0.f};
  for (int s = 0; s < 256; ++s) {
    float k = (s <= t) ? hf[t - s] : hb[s - t];
#pragma unroll
    for (int b = 0; b < 4; ++b) acc[b] += k * us[b * 256 + s];
  }
  const float Dc = P.hy_D[l * 1024 + c];
#pragma unroll
  for (int b = 0; b < 4; ++b) {
    int row = TX + b * 256 + t;
    P.xh[(size_t)row * 2048 + 1024 + c] = f2bf(x0c[b] * (acc[b] + Dc * uu[b]));
  }
  __syncthreads();
}
__device__ void phase_d(const Params& P, int l, char* smem, char* smem_all) {
  const int nhx = 1024, nhc = (l == 0) ? 1024 : 0;
  for (int pr = blockIdx.x; pr < ((nhx + nhc) >> 1); pr += gridDim.x) {
    const int id = 2 * pr + VHALF;
    if (id < nhx) hyena_x_task(P, l, id, smem);
    else hyena_ctx_task(P, id - nhx, smem);
  }
  __syncthreads();
  const int nqm = (l == 0) ? 68 : 64;
  const int nq = nqm * 6, nkv = 68 * 8;
  for (int L = blockIdx.x; L < nq + nkv; L += gridDim.x) {
    if (L < nkv) kv_gemm_task(P, l, L >> 3, L & 7, smem_all);
    else { int i = L - nkv; q_gemm_task(P, l, i / 6, i % 6, smem_all); }
  }
}

__device__ void attn_task(const Params& P, int b, int h, int qrow0, int nkt, char* smem) {
  const int tid = launder((int)threadIdx.x), lane = tid & 63, w = tid >> 6, l15 = lane & 15, quad = lane >> 4;
  bf16x8 qf[2][6];
#pragma unroll
  for (int m = 0; m < 2; ++m)
#pragma unroll
    for (int ks = 0; ks < 6; ++ks)
      qf[m][ks] = *(const bf16x8*)(P.qbuf + (size_t)(qrow0 + w * 32 + m * 16 + l15) * QW + h * 192 + ks * 32 + quad * 8);
  const bf16* Kg = P.Kn + ((size_t)b * 8 + h) * LK * 128;
  const bf16* Rg = P.kr + (size_t)b * LK * 64;
  const bf16* Vg = P.vT + ((size_t)b * 8 + h) * 128 * LK;
  uint4 sk0, sk1, sr0, sv0, sv1;
  const int vok = (tid >> 4) * 128 + (tid & 15) * 8;
  const int vor = (tid >> 3) * 64 + (tid & 7) * 8;
  const int vov = (tid >> 3) * LK + (tid & 7) * 8;
  const int lok = (tid >> 4) * 400 + (tid & 15) * 16;
  const int lor = (tid >> 3) * 400 + 256 + (tid & 7) * 16;
  const int lov = 25600 + (tid >> 3) * 144 + (tid & 7) * 16;
#define GLOADKV(kt) do { const bf16* kb = Kg + (size_t)(kt) * 64 * 128; const bf16* rb = Rg + (size_t)(kt) * 64 * 64; const bf16* vb = Vg + (kt) * 64; \
    sk0 = *(const uint4*)(kb + vok); sk1 = *(const uint4*)(kb + (vok + 32 * 128)); sr0 = *(const uint4*)(rb + vor); \
    sv0 = *(const uint4*)(vb + vov); sv1 = *(const uint4*)(vb + (vov + 64 * LK)); } while (0)
#define LSTOREKV(bufp) do { *(uint4*)((bufp) + lok) = sk0; *(uint4*)((bufp) + lok + 32 * 400) = sk1; *(uint4*)((bufp) + lor) = sr0; \
    *(uint4*)((bufp) + lov) = sv0; *(uint4*)((bufp) + lov + 64 * 144) = sv1; } while (0)
  f32x4 oacc[8][2];
#pragma unroll
  for (int nd = 0; nd < 8; ++nd) { oacc[nd][0] = f32x4{0.f, 0.f, 0.f, 0.f}; oacc[nd][1] = f32x4{0.f, 0.f, 0.f, 0.f}; }
  float mrow[2] = {-1e30f, -1e30f}, lrow[2] = {0.f, 0.f};
  GLOADKV(0);
  LSTOREKV(smem);
  __syncthreads();
  for (int kt = 0; kt < nkt; ++kt) {
    const bool more = kt + 1 < nkt;
    const char* Ks = smem + (kt & 1) * 44032;
    const char* Vs = Ks + 25600;
    char* nbuf = smem + ((kt + 1) & 1) * 44032;
    if (more) GLOADKV(kt + 1);
    f32x4 s[4][2];
#pragma unroll
    for (int n = 0; n < 4; ++n) { s[n][0] = f32x4{0.f, 0.f, 0.f, 0.f}; s[n][1] = f32x4{0.f, 0.f, 0.f, 0.f}; }
    __builtin_amdgcn_s_setprio(1);
#pragma unroll
    for (int ks = 0; ks < 6; ++ks) {
#pragma unroll
      for (int n = 0; n < 4; ++n) {
        bf16x8 a = *(const bf16x8*)(Ks + (n * 16 + l15) * 400 + ks * 64 + quad * 16);
        s[n][0] = __builtin_amdgcn_mfma_f32_16x16x32_bf16(a, qf[0][ks], s[n][0], 0, 0, 0);
        s[n][1] = __builtin_amdgcn_mfma_f32_16x16x32_bf16(a, qf[1][ks], s[n][1], 0, 0, 0);
      }
      if (ks & 1) __builtin_amdgcn_sched_barrier(0);
    }
    __builtin_amdgcn_s_setprio(0);
    bf16x8 pb[2][2];
#pragma unroll
    for (int m = 0; m < 2; ++m) {
      float mx = vmax3(s[0][m][0], s[0][m][1], s[0][m][2]);
      mx = vmax3(mx, s[0][m][3], s[1][m][0]); mx = vmax3(mx, s[1][m][1], s[1][m][2]); mx = vmax3(mx, s[1][m][3], s[2][m][0]);
      mx = vmax3(mx, s[2][m][1], s[2][m][2]); mx = vmax3(mx, s[2][m][3], s[3][m][0]); mx = vmax3(mx, s[3][m][1], s[3][m][2]);
      mx = vmax(mx, s[3][m][3]);
      mx = vmax(mx, __shfl_xor(mx, 16));
      mx = vmax(mx, __shfl_xor(mx, 32));
      float mn = vmax(mrow[m], mx);
      float alpha = __builtin_amdgcn_exp2f(mrow[m] - mn);
      mrow[m] = mn;
      float ps = 0.f;
#pragma unroll
      for (int n = 0; n < 4; ++n)
#pragma unroll
        for (int j = 0; j < 4; ++j) { float p = __builtin_amdgcn_exp2f(s[n][m][j] - mn); s[n][m][j] = p; ps += p; }
      lrow[m] = lrow[m] * alpha + ps;
      if (!__all(alpha == 1.f)) {
#pragma unroll
        for (int nd = 0; nd < 8; ++nd) { oacc[nd][m][0] *= alpha; oacc[nd][m][1] *= alpha; oacc[nd][m][2] *= alpha; oacc[nd][m][3] *= alpha; }
      }
#pragma unroll
      for (int k2 = 0; k2 < 2; ++k2) {
        uint4 pk;
        pk.x = pack2(s[2 * k2][m][0], s[2 * k2][m][1]); pk.y = pack2(s[2 * k2][m][2], s[2 * k2][m][3]);
        pk.z = pack2(s[2 * k2 + 1][m][0], s[2 * k2 + 1][m][1]); pk.w = pack2(s[2 * k2 + 1][m][2], s[2 * k2 + 1][m][3]);
        pb[m][k2] = *(bf16x8*)&pk;
      }
    }
    __builtin_amdgcn_sched_barrier(0);
    __builtin_amdgcn_s_setprio(1);
#pragma unroll
    for (int nd = 0; nd < 8; ++nd) {
      if ((nd & 1) == 0) __builtin_amdgcn_sched_barrier(0);
#pragma unroll
      for (int k2 = 0; k2 < 2; ++k2) {
        const char* vp = Vs + (nd * 16 + l15) * 144 + k2 * 64 + quad * 8;
        uint2 lo = *(const uint2*)(vp), hi = *(const uint2*)(vp + 32);
        uint4 av = uint4{lo.x, lo.y, hi.x, hi.y};
        bf16x8 a = *(bf16x8*)&av;
        oacc[nd][0] = __builtin_amdgcn_mfma_f32_16x16x32_bf16(a, pb[0][k2], oacc[nd][0], 0, 0, 0);
        oacc[nd][1] = __builtin_amdgcn_mfma_f32_16x16x32_bf16(a, pb[1][k2], oacc[nd][1], 0, 0, 0);
      }
    }
    __builtin_amdgcn_s_setprio(0);
    if (more) LSTOREKV(nbuf);
    __syncthreads();
  }
#undef GLOADKV
#undef LSTOREKV
#pragma unroll
  for (int m = 0; m < 2; ++m) {
    float lt = lrow[m];
    lt += __shfl_xor(lt, 16);
    lt += __shfl_xor(lt, 32);
    float inv = 1.f / lt;
    int row = qrow0 + w * 32 + m * 16 + l15;
#pragma unroll
    for (int nd = 0; nd < 8; ++nd) {
      uint2 o; o.x = pack2(oacc[nd][m][0] * inv, oacc[nd][m][1] * inv); o.y = pack2(oacc[nd][m][2] * inv, oacc[nd][m][3] * inv);
      *(uint2*)(P.xh + (size_t)row * 2048 + h * 128 + nd * 16 + quad * 4) = o;
    }
  }
}
__device__ void phase_attn(const Params& P, int l, char* smem) {
  const int nx = 512, nc = (l == 0) ? 32 : 0;
  for (int id = blockIdx.x; id < nx + nc; id += gridDim.x) {
    if (id < nx) {
      int j = id >> 3;
      int bh = (id & 7) + 8 * (j >> 4), qt = j & 15;
      int b = bh >> 3, h = bh & 7;
      attn_task(P, b, h, b * 4096 + qt * 256, 68, smem);
    } else {
      int bh = id - nx;
      int b = bh >> 3, h = bh & 7;
      attn_task(P, b, h, TX + b * 256, 4, smem);
    }
  }
}

__device__ __forceinline__ void unpack8(uint4 v, float* f) {
  f[0] = __uint_as_float(v.x << 16); f[1] = __uint_as_float(v.x & 0xffff0000u);
  f[2] = __uint_as_float(v.y << 16); f[3] = __uint_as_float(v.y & 0xffff0000u);
  f[4] = __uint_as_float(v.z << 16); f[5] = __uint_as_float(v.z & 0xffff0000u);
  f[6] = __uint_as_float(v.w << 16); f[7] = __uint_as_float(v.w & 0xffff0000u);
}
__device__ __forceinline__ void merge_row(const Params& P, int row, const char* yh_lds  , int lane) {
  bf16* yr = P.xh + (size_t)row * 2048;
  const bf16* gr = P.pa + (size_t)row * NPA;
  float o[2][8], y[2][8];
  float so = 0.f, sy = 0.f;
#pragma unroll
  for (int i = 0; i < 2; ++i) {
    int col = i * 512 + lane * 8;
    unpack8(*(const uint4*)(yr + col), o[i]);
    uint4 yv = yh_lds ? *(const uint4*)(yh_lds + col * 2) : *(const uint4*)(yr + 1024 + col);
    unpack8(yv, y[i]);
#pragma unroll
    for (int e = 0; e < 8; ++e) { so += o[i][e] * o[i][e]; sy += y[i][e] * y[i][e]; }
  }
  so = wave_sum(so); sy = wave_sum(sy);
  float rm = rsqrtf(so * (1.f / 1024.f) + EPSN), rh = rsqrtf(sy * (1.f / 1024.f) + EPSN);
#pragma unroll
  for (int i = 0; i < 2; ++i) {
    int col = i * 512 + lane * 8;
    float gm[8], gh[8];
    unpack8(*(const uint4*)(gr + 832 + col), gm);
    unpack8(*(const uint4*)(gr + 1856 + col), gh);
    uint4 a, b;
    a.x = pack2(o[i][0] * rm * siluf(gm[0]), o[i][1] * rm * siluf(gm[1]));
    a.y = pack2(o[i][2] * rm * siluf(gm[2]), o[i][3] * rm * siluf(gm[3]));
    a.z = pack2(o[i][4] * rm * siluf(gm[4]), o[i][5] * rm * siluf(gm[5]));
    a.w = pack2(o[i][6] * rm * siluf(gm[6]), o[i][7] * rm * siluf(gm[7]));
    b.x = pack2(y[i][0] * rh * siluf(gh[0]), y[i][1] * rh * siluf(gh[1]));
    b.y = pack2(y[i][2] * rh * siluf(gh[2]), y[i][3] * rh * siluf(gh[3]));
    b.z = pack2(y[i][4] * rh * siluf(gh[4]), y[i][5] * rh * siluf(gh[5]));
    b.w = pack2(y[i][6] * rh * siluf(gh[6]), y[i][7] * rh * siluf(gh[7]));
    *(uint4*)(yr + col) = a;
    *(uint4*)(yr + 1024 + col) = b;
  }
}
__device__ void merge_x_task(const Params& P, int task, char* smem) {
  const int tid = launder((int)threadIdx.x & 255), lane = tid & 63, w = tid >> 6;
  const int b = task >> 7, tt = task & 127;
  constexpr int RS = 2064;
#pragma unroll 4
  for (int i = 0; i < 16; ++i) {
    int id = tid + 256 * i, cch = id >> 2, q = id & 3;
    uint4 v = *(const uint4*)(P.yhT + ((size_t)b * 1024 + cch) * 4096 + tt * 32 + q * 8);
    unsigned uu[4] = {v.x, v.y, v.z, v.w};
#pragma unroll
    for (int e = 0; e < 4; ++e) {
      *(bf16*)(smem + (q * 8 + 2 * e) * RS + cch * 2) = (bf16)(uu[e] & 0xffffu);
      *(bf16*)(smem + (q * 8 + 2 * e + 1) * RS + cch * 2) = (bf16)(uu[e] >> 16);
    }
  }
  HSYNC();
  for (int rr = 0; rr < 8; ++rr) {
    int tk = w * 8 + rr;
    merge_row(P, b * 4096 + tt * 32 + tk, smem + tk * RS, lane);
  }
  HSYNC();
}
__device__ void phase_merge(const Params& P, int l, char* smem) {
  const int nx = 512, nc = (l == 0) ? 256 : 0, nw = 0;
  for (int id = VBID; id < nx + nc + nw; id += VGRID) {
    if (id < nx) merge_x_task(P, id, smem);
    else if (id < nx + nc) { int row = TX + (id - nx) * 4 + (launder((int)threadIdx.x & 255) >> 6); merge_row(P, row, nullptr, launder((int)threadIdx.x & 255) & 63); }
    else win_transpose_task(P, 1, id - nx - nc, smem);
  }
}

__device__ void phase_gemm_out(const Params& P, int l, char* smem) {
  const int nM = (l == 0) ? 68 : 64, nN = 8;
  for (int L = blockIdx.x; L < nM * nN; L += gridDim.x) {
    int mt, nt;
    g2_tile(L, nM, nN, mt, nt);
    f32x4 acc[2][2][4][2];
    const int row0 = mt * 256, col0 = nt * 256;
    gemm256_8p(P.xh + (size_t)row0 * DM, P.wT_out + (size_t)l * DM * DM + (size_t)col0 * DM, smem, acc);
    const int tid = launder((int)threadIdx.x), lane = tid & 63, w = tid >> 6, wr = w >> 2, wc = w & 3, l15 = lane & 15, quad = lane >> 4;
#pragma unroll
    for (int ai = 0; ai < 2; ++ai)
#pragma unroll
      for (int bj = 0; bj < 2; ++bj)
#pragma unroll
        for (int m = 0; m < 4; ++m)
#pragma unroll
          for (int n = 0; n < 2; ++n)
#pragma unroll
            for (int j = 0; j < 4; ++j) {
              int row = row0 + ai * 128 + wr * 64 + m * 16 + quad * 4 + j, col = col0 + bj * 128 + wc * 32 + n * 16 + l15;
              P.z[(size_t)row * 2048 + col] = acc[ai][bj][m][n][j];
            }
    __syncthreads();
  }
  if (l == 0) {
    const int rem = (nM * nN) % (int)gridDim.x;
    const int nidle = (int)gridDim.x - rem;
    if ((int)blockIdx.x >= rem) {
      const int vb = ((int)blockIdx.x - rem) + VHALF * nidle;
      for (int task = vb; task < 3072; task += 2 * nidle) win_transpose_task(P, 1, task, smem + VHALF * HALF_LDS);
    }
  }
}

__device__ void phase_a(const Params& P, char* smem) {
  const int n0 = 192, n1 = n0 + 2112, n2 = n1, n3 = n2 + 3072, n4 = n3 + 384, n5 = n4 + 256, n6 = n5 + 2048;
  for (int id = VBID; id < n6 + 1; id += VGRID) {
    if (id < n0) modulation_task(P, id, smem);
    else if (id < n1) h2_task(P, id - n0, smem);
    else if (id == n6) rope_table_task(P);
    else if (id < n3) win_transpose_task(P, 0, id - n2, smem);
    else if (id < n4) {
      int i = id - n3, l = i / 192, r = i % 192, nt = r >> 3, kt = r & 7;
      transpose_tile(P.w_uq + (size_t)l * 512 * QW, QW, kt * 64, nt * 64, P.wT_uq + (size_t)l * QW * 512, 512, nt * 64, P.q_norm_g + l * 512, false, smem);
    } else if (id < n5) {
      int i = id - n4, l = i / 128, r = i % 128, nt = r >> 2, kt = r & 3;
      transpose_tile(P.w_ukv + (size_t)l * 256 * 2048, 2048, kt * 64, nt * 64, P.wT_ukv + (size_t)l * 2048 * 256, 256, nt * 64, P.kv_norm_g + l * 256, false, smem);
    } else {
      int i = id - n5, l = i / 1024, r = i % 1024, nt = r >> 5, kt = r & 31;
      const float* gk = (kt < 16) ? (P.grp_g_mla + l * 1024) : (P.grp_g_hy + l * 1024 - 1024);
      transpose_tile(P.w_out + (size_t)l * DM * DM, DM, kt * 64, nt * 64, P.wT_out + (size_t)l * DM * DM, DM, nt * 64, gk, false, smem);
    }
  }
}


#define XB_TMO      128
#define XB_XCNT(j)  (256  + 64 * (j))
#define XB_XSUB(j)  (1280 + 64 * (j))
#define XB_XGEN(j)  (2304 + 64 * (j))
#define XB_TOP      3328
#define XB_TOPGEN   3392
#define XCD_BAR_WORDS 3456
#define XB_SPIN_CAP (1u << 20)
#define LAS __attribute__((address_space(3)))
__device__ __forceinline__ unsigned xb_ld(unsigned* p) { return __hip_atomic_load(p, __ATOMIC_RELAXED, __HIP_MEMORY_SCOPE_AGENT); }
__device__ __forceinline__ unsigned xb_add(unsigned* p, unsigned v) { return __hip_atomic_fetch_add(p, v, __ATOMIC_RELAXED, __HIP_MEMORY_SCOPE_AGENT); }
__device__ __forceinline__ unsigned xb_xcc_id() { return (unsigned)__builtin_amdgcn_s_getreg((3 << 11) | 20) & 0xFu; }
#define XB_SPIN(cond, bar) do { unsigned _sp = 0; while (cond) { __builtin_amdgcn_s_sleep(1); \
    if ((++_sp & 255u) == 0u) { if (xb_ld(&(bar)[XB_TMO])) break; if (_sp > XB_SPIN_CAP) { atomicAdd(&(bar)[XB_TMO], 1u); break; } } } } while (0)
struct XcdBarrier { unsigned* bar; unsigned x; volatile LAS unsigned* st; };
__device__ __forceinline__ XcdBarrier xcd_barrier_post(unsigned* bar, volatile LAS unsigned* st) {
  XcdBarrier b; b.bar = bar; b.x = xb_xcc_id(); b.st = st;
  if (threadIdx.x == 0) (void)xb_add(&bar[XB_XCNT(b.x)], 1u);
  return b;
}
__device__ __forceinline__ void xcd_barrier_complete(unsigned* bar, unsigned x, unsigned& nloc, unsigned& nx) {
  const unsigned G = gridDim.x * gridDim.y * gridDim.z;
  unsigned sum, cnt, mine, sp = 0u;
  for (;;) {
    sum = 0u; cnt = 0u; mine = 0u;
#pragma unroll
    for (unsigned j = 0; j < 16; ++j) { const unsigned c = xb_ld(&bar[XB_XCNT(j)]); sum += c; cnt += (c > 0u) ? 1u : 0u; mine = (j == x) ? c : mine; }
    if (sum == G) break;
    __builtin_amdgcn_s_sleep(1);
    if ((++sp & 255u) == 0u) { if (xb_ld(&bar[XB_TMO])) break; if (sp > XB_SPIN_CAP) { atomicAdd(&bar[XB_TMO], 1u); break; } }
  }
  nloc = mine > 0u ? mine : 1u; nx = cnt > 0u ? cnt : 1u;
}
__device__ __forceinline__ void xcd_barrier(const XcdBarrier& b) {
  asm volatile("s_waitcnt vmcnt(0)" ::: "memory");
  __syncthreads();
  if (threadIdx.x == 0) {
    unsigned* bar = b.bar;
    __builtin_amdgcn_s_waitcnt(0);
    unsigned nloc = b.st[0], nx = b.st[1];
    if (nloc == 0u) { xcd_barrier_complete(bar, b.x, nloc, nx); b.st[0] = nloc; b.st[1] = nx; }
    const unsigned old = xb_add(&bar[XB_XSUB(b.x)], 1u);
    const unsigned gen = old / nloc;
    if (old + 1u == (gen + 1u) * nloc) {
      __builtin_amdgcn_fence(__ATOMIC_RELEASE, "agent");
      asm volatile("s_waitcnt vmcnt(0)" ::: "memory");
      const unsigned og = xb_add(&bar[XB_TOP], 1u);
      const unsigned tg = og / nx;
      if (og + 1u == (tg + 1u) * nx) xb_add(&bar[XB_TOPGEN], 1u);
      else XB_SPIN(xb_ld(&bar[XB_TOPGEN]) == tg, bar);
      __builtin_amdgcn_fence(__ATOMIC_ACQUIRE, "agent");
      xb_add(&bar[XB_XGEN(b.x)], 1u);
      asm volatile("s_waitcnt vmcnt(0)" ::: "memory");
    } else {
      XB_SPIN(xb_ld(&bar[XB_XGEN(b.x)]) == gen, bar);
      __builtin_amdgcn_fence(__ATOMIC_ACQUIRE, "agent");
      asm volatile("s_waitcnt vmcnt(0)" ::: "memory");
    }
  }
  __syncthreads();
}

#ifndef MINB
#define MINB 2
#endif
__global__ void __launch_bounds__(512, MINB) hymba_fwd(Params Pin) {
  extern __shared__ __attribute__((aligned(1024))) char smem_all[];
  char* smem = smem_all + VHALF * HALF_LDS;
  cg::grid_group grid = cg::this_grid();
#ifndef PM
#define PM 0xffff
#endif
  typedef const Params __attribute__((address_space(4))) * KP4;
#if defined(__HIP_DEVICE_COMPILE__)
#define GETP() ([&]() { KP4 kp = (KP4)__builtin_amdgcn_kernarg_segment_ptr(); asm volatile("" : "+s"(kp)); Params q = *kp; return q; }())
#else
#define GETP() Pin
#endif
  volatile LAS unsigned* xst = (volatile LAS unsigned*)(smem_all + LDS_BYTES - 16);
  if (threadIdx.x < 4) xst[threadIdx.x] = 0u;
  if (threadIdx.x >= 8 && threadIdx.x < 16) ((volatile LAS unsigned*)(smem_all + LDS_BYTES - 64))[threadIdx.x - 8] = 0u;
  __syncthreads();
  (void)xcd_barrier_post(Pin.bar, xst);
#define XBAR() do { XcdBarrier xb_; xb_.bar = GETP().bar; xb_.x = xb_xcc_id(); xb_.st = (volatile LAS unsigned*)(smem_all + LDS_BYTES - 16); xcd_barrier(xb_); } while (0)
  if (PM & 1) phase_a(GETP(), smem);
  if (Pin.reps[6] != 0) grid.sync();
  XBAR();
  if (PM & 2) phase_prenorm0(GETP());
  XBAR();
#pragma unroll 1
  for (int l = 0; l < 2; ++l) {
#ifndef REP
#define REP 0
#endif
    const int r0 = Pin.reps[0], r1 = Pin.reps[1], r2 = Pin.reps[2], r3 = Pin.reps[3];
#pragma unroll 1
    for (int r = 0; r < r0; ++r) { phase_gemm_in(GETP(), l, smem_all); XBAR(); }
#pragma unroll 1
    for (int r = 0; r < r1; ++r) { phase_d(GETP(), l, smem, smem_all); XBAR(); }
#pragma unroll 1
    for (int r = 0; r < r2; ++r) { phase_attn(GETP(), l, smem_all); XBAR(); }
    if (PM & 32) phase_merge(GETP(), l, smem);
    XBAR();
#pragma unroll 1
    for (int r = 0; r < r3; ++r) { phase_gemm_out(GETP(), l, smem_all); XBAR(); }
    if (PM & 128) phase_post(GETP(), l);
    if (l == 0) XBAR();
  }
}

extern "C" void kernel_launch(void* const* d_in, const int* in_sizes, int n_in, void* d_out, int out_size, void* d_ws, size_t ws_size,
                              hipStream_t stream) {
  static int grid_blocks = 0;
  if (grid_blocks == 0) {
    int dev = 0, cus = 0, per_cu = 0;
    hipGetDevice(&dev);
    hipDeviceGetAttribute(&cus, hipDeviceAttributeMultiprocessorCount, dev);
    if (hipFuncSetAttribute((const void*)hymba_fwd, hipFuncAttributeMaxDynamicSharedMemorySize, LDS_BYTES) != hipSuccess) {
      fprintf(stderr, "hipFuncSetAttribute failed\n"); grid_blocks = -1; return;
    }
    hipOccupancyMaxActiveBlocksPerMultiprocessor(&per_cu, (const void*)hymba_fwd, NT, LDS_BYTES);
    if (per_cu < 1) per_cu = 1;
    if (per_cu > 1) per_cu = 1;
    grid_blocks = cus * per_cu;
  }
  if (grid_blocks < 0) return;
  Params p{};
  const float** pin = (const float**)&p;
  for (int i = 0; i < 25; ++i) pin[i] = (const float*)d_in[i];
  p.out = (float*)d_out;
  char* ws = (char*)d_ws;
  size_t off = 0;
  auto take = [&](size_t bytes) { char* r = ws + off; off += (bytes + 255) & ~(size_t)255; return r; };
  p.wT_in = (bf16*)take((size_t)NPADW * DM * 2);
  p.wT_uq = (bf16*)take((size_t)2 * QW * 512 * 2);
  p.wT_ukv = (bf16*)take((size_t)2 * 2048 * 256 * 2);
  p.wT_out = (bf16*)take((size_t)2 * DM * DM * 2);
  p.mod = (float*)take((size_t)2 * 5 * 6144 * 4);
  p.h2T = (bf16*)take((size_t)2 * 64 * 4096 * 2);
  p.h2cT = (float*)take((size_t)64 * 256 * 4);
  p.rope = (float*)take((size_t)64 * 16 * 2 * 4);
  p.xh = (bf16*)take((size_t)TT * DM * 2);
  p.pa = (bf16*)take((size_t)TT * NPA * 2);
  p.pT = (bf16*)take((size_t)4 * NHYC * 4096 * 2);
  p.pchy = (bf16*)take((size_t)TC * NHYC * 2);
  p.z = (float*)p.pa;
  p.qbuf = (bf16*)take((size_t)TT * QW * 2);
  p.Kn = (bf16*)take((size_t)4 * 8 * LK * 128 * 2);
  p.kr = (bf16*)take((size_t)4 * LK * 64 * 2);
  p.vT = (bf16*)take((size_t)4 * 8 * 128 * LK * 2);
  p.yhT = (bf16*)take((size_t)4 * 1024 * 4096 * 2);
  p.ctx1 = (float*)take((size_t)TC * DM * 4);
  p.kfg = (float*)take((size_t)grid_blocks * 2 * 2 * 4096 * 8);
  p.bar = (unsigned*)take((size_t)XCD_BAR_WORDS * 4);
  if (off > ws_size) { fprintf(stderr, "workspace too small: need %zu have %zu\n", off, ws_size); return; }
#ifndef REPS
#define REPS 1, 1, 1, 1
#endif
  { const int rr[4] = {REPS}; for (int i = 0; i < 4; ++i) p.reps[i] = rr[i]; }
  if (hipMemsetAsync(p.bar, 0, (size_t)XCD_BAR_WORDS * 4, stream) != hipSuccess) { fprintf(stderr, "memset failed\n"); return; }
  void* args[] = {&p};
  hipError_t e = hipLaunchCooperativeKernel((void*)hymba_fwd, dim3(grid_blocks), dim3(NT), args, LDS_BYTES, stream);
  if (e != hipSuccess) fprintf(stderr, "cooperative launch failed: %s (grid %d)\n", hipGetErrorString(e), grid_blocks);
}
```

```cpp
#include <hip/hip_runtime.h>
#include <hip/hip_cooperative_groups.h>
#include <cstdio>
namespace cg = cooperative_groups;

typedef unsigned short bf16;
using bf16x8 = __attribute__((ext_vector_type(8))) short;
using f32x4 = __attribute__((ext_vector_type(4))) float;

constexpr int DM = 2048, SEQ = 4096, CTXL = 256;
constexpr int TX = 16384, TC = 1024, TT = 17408;
constexpr int NIN = 5952, NPA = 2944, NHYC = 3072, NPADW = 6144;
constexpr int LK = 4352;
constexpr int QW = 1536;
constexpr float EPSN = 1e-6f;
constexpr float QSCALE = 0.07216878364870322f * 1.4426950408889634f;
constexpr int HALF_LDS = 69632;
constexpr int LDS_BYTES = 2 * HALF_LDS + 256;
constexpr int NT = 512;
#define VHALF (__builtin_amdgcn_readfirstlane((int)(threadIdx.x >> 8)))
#define VBID ((int)blockIdx.x + VHALF * (int)gridDim.x)
#define VGRID ((int)gridDim.x * 2)

struct Params {
  const float *x, *c, *ctx, *c_ctx, *ada_w, *ada_b, *pre_g, *w_in, *q_norm_g, *w_uq, *kv_norm_g, *w_ukv, *conv_w, *conv_b,
      *filt_w1, *filt_b1, *filt_freq, *filt_w2, *filt_b2, *filt_w3, *hy_D, *grp_g_mla, *grp_g_hy, *w_out, *post_g;
  float* out;
  bf16 *wT_in, *wT_uq, *wT_ukv, *wT_out;
  float *mod, *h2cT, *rope;
  bf16* h2T;
  bf16 *xh, *pa, *pT, *pchy;
  float* z;
  bf16 *qbuf, *Kn, *kr, *vT, *yhT;
  float* ctx1;
  float* kfg;
  unsigned* bar;
  int reps[8];
};

extern __shared__ __attribute__((aligned(1024))) char smem_dyn_[];
__device__ __forceinline__ void half_sync() {
  __builtin_amdgcn_fence(__ATOMIC_RELEASE, "workgroup");
  volatile __attribute__((address_space(3))) unsigned* ctr =
      (volatile __attribute__((address_space(3))) unsigned*)(smem_dyn_ + LDS_BYTES - 64) + VHALF * 4;
  if ((threadIdx.x & 63) == 0) {
    unsigned old = __hip_atomic_fetch_add((__attribute__((address_space(3))) unsigned*)ctr, 1u, __ATOMIC_RELAXED, __HIP_MEMORY_SCOPE_WORKGROUP);
    unsigned target = (old & ~3u) + 4u;
    while ((int)(__hip_atomic_load((__attribute__((address_space(3))) unsigned*)ctr, __ATOMIC_RELAXED, __HIP_MEMORY_SCOPE_WORKGROUP) - target) < 0) __builtin_amdgcn_s_sleep(1);
  }
  __builtin_amdgcn_fence(__ATOMIC_ACQUIRE, "workgroup");
}
#define HSYNC() half_sync()

__device__ __forceinline__ bf16 f2bf(float f) {
  unsigned u = __float_as_uint(f);
  u += 0x7fffu + ((u >> 16) & 1u);
  return (bf16)(u >> 16);
}
__device__ __forceinline__ float bf2f(bf16 h) { return __uint_as_float(((unsigned)h) << 16); }
__device__ __forceinline__ unsigned pack2(float a, float b) { unsigned r; asm volatile("v_cvt_pk_bf16_f32 %0, %1, %2" : "=v"(r) : "v"(a), "v"(b)); return r; }
__device__ __forceinline__ float wave_sum(float v) {
#pragma unroll
  for (int o = 32; o > 0; o >>= 1) v += __shfl_xor(v, o);
  return v;
}
__device__ __forceinline__ int launder(int v) { asm volatile("" : "+v"(v)); return v; }
__device__ __forceinline__ float launderf(float v) { asm volatile("" : "+v"(v)); return v; }
__device__ __forceinline__ float vmax(float a, float b) { float r; asm("v_max_f32 %0, %1, %2" : "=v"(r) : "v"(a), "v"(b)); return r; }
__device__ __forceinline__ float vmax3(float a, float b, float c) { float r; asm("v_max3_f32 %0, %1, %2, %3" : "=v"(r) : "v"(a), "v"(b), "v"(c)); return r; }
__device__ __forceinline__ float siluf(float v) { return v / (1.f + __expf(-v)); }

#define HD __device__ __forceinline__
struct cf { float x, y; };
HD cf cmul(cf a, cf b) { return cf{a.x * b.x - a.y * b.y, a.x * b.y + a.y * b.x}; }
HD cf cmulc(cf a, cf b) { return cf{a.x * b.x + a.y * b.y, a.y * b.x - a.x * b.y}; }
HD cf cadd(cf a, cf b) { return cf{a.x + b.x, a.y + b.y}; }
HD cf csub(cf a, cf b) { return cf{a.x - b.x, a.y - b.y}; }
template <bool INV> HD void dft4(cf& a0, cf& a1, cf& a2, cf& a3) {
  cf s02 = cadd(a0, a2), d02 = csub(a0, a2), s13 = cadd(a1, a3), d13 = csub(a1, a3);
  cf r = INV ? cf{-d13.y, d13.x} : cf{d13.y, -d13.x};
  a0 = cadd(s02, s13); a2 = csub(s02, s13); a1 = cadd(d02, r); a3 = csub(d02, r);
}
#define W16C1 0.92387953251128674f
#define W16S1 0.38268343236508977f
#define W16R2 0.70710678118654752f
template <bool INV> HD cf w16(int m) {
  float c, s;
  switch (m) {
    case 0: c = 1.f; s = 0.f; break;
    case 1: c = W16C1; s = W16S1; break;
    case 2: c = W16R2; s = W16R2; break;
    case 3: c = W16S1; s = W16C1; break;
    case 4: c = 0.f; s = 1.f; break;
    case 6: c = -W16R2; s = W16R2; break;
    default: c = -W16C1; s = -W16S1; break;
  }
  return cf{c, INV ? s : -s};
}
template <bool INV> HD void dft16_nt(cf* x) {
#pragma unroll
  for (int b = 0; b < 4; ++b) dft4<INV>(x[b], x[4 + b], x[8 + b], x[12 + b]);
#pragma unroll
  for (int c = 1; c < 4; ++c)
#pragma unroll
    for (int b = 1; b < 4; ++b) x[4 * c + b] = cmul(x[4 * c + b], w16<INV>(b * c));
#pragma unroll
  for (int c = 0; c < 4; ++c) dft4<INV>(x[4 * c], x[4 * c + 1], x[4 * c + 2], x[4 * c + 3]);
}
template <bool INV> HD void dft16_tn(cf* x) {
#pragma unroll
  for (int c = 0; c < 4; ++c) dft4<INV>(x[4 * c], x[4 * c + 1], x[4 * c + 2], x[4 * c + 3]);
#pragma unroll
  for (int c = 1; c < 4; ++c)
#pragma unroll
    for (int b = 1; b < 4; ++b) x[4 * c + b] = cmul(x[4 * c + b], w16<INV>(b * c));
#pragma unroll
  for (int b = 0; b < 4; ++b) dft4<INV>(x[b], x[4 + b], x[8 + b], x[12 + b]);
}
#define KOF(r) (((r) >> 2) + 4 * ((r) & 3))
#define PADI(p) ((p) + ((p) >> 4))
struct FftTw { cf c1, c2, c4, c5; };
HD void fwd_p1(cf* x, int t, const FftTw& tw, cf* lds) {
  dft16_nt<false>(x);
  __builtin_amdgcn_sched_barrier(0);
  cf pw = cf{1.f, 0.f};
#pragma unroll
  for (int k = 0; k < 16; ++k) { lds[(t + (t >> 4)) + 272 * k] = cmul(x[KOF(k)], pw); pw = cmul(pw, tw.c1); if ((k & 3) == 3) __builtin_amdgcn_sched_barrier(0); }
}
HD void fwd_p2(cf* x, int t, const FftTw& tw, cf* lds) {
  int k1 = t >> 4, n2b = t & 15;
#pragma unroll
  for (int j = 0; j < 16; ++j) x[j] = lds[(272 * k1 + n2b) + 17 * j];
  __builtin_amdgcn_sched_barrier(0);
  dft16_nt<false>(x);
  __builtin_amdgcn_sched_barrier(0);
  cf pw = cf{1.f, 0.f};
#pragma unroll
  for (int k = 0; k < 16; ++k) { lds[(272 * k1 + n2b) + 17 * k] = cmul(x[KOF(k)], pw); pw = cmul(pw, tw.c2); __builtin_amdgcn_sched_barrier(0); }
}
HD void fwd_p3(cf* x, int t, cf* lds) {
#pragma unroll
  for (int j = 0; j < 16; ++j) x[j] = lds[17 * t + j];
  dft16_nt<false>(x);
}
HD void inv_p3(cf* x, int t, const FftTw& tw, cf* lds) {
  dft16_tn<true>(x);
  __builtin_amdgcn_sched_barrier(0);
  cf pw = cf{1.f, 0.f};
#pragma unroll
  for (int n = 0; n < 16; ++n) { lds[17 * t + n] = cmulc(x[n], pw); pw = cmul(pw, tw.c2); __builtin_amdgcn_sched_barrier(0); }
}
HD void inv_p2(cf* x, int t, const FftTw& tw, cf* lds) {
  int k1 = t >> 4, n2b = t & 15;
#pragma unroll
  for (int j = 0; j < 16; ++j) x[j] = lds[(272 * k1 + n2b) + 17 * j];
  dft16_nt<true>(x);
  __builtin_amdgcn_sched_barrier(0);
  cf pw = tw.c4;
#pragma unroll
  for (int k = 0; k < 16; ++k) { lds[(272 * k1 + n2b) + 17 * k] = cmulc(x[KOF(k)], pw); pw = cmul(pw, tw.c5); if ((k & 3) == 3) __builtin_amdgcn_sched_barrier(0); }
}
HD void inv_p1(cf* x, int t, cf* lds) {
#pragma unroll
  for (int r = 0; r < 16; ++r) x[r] = lds[(t + (t >> 4)) + 272 * KOF(r)];
  dft16_tn<true>(x);
}
HD void fft_fwd(cf* x, int t, const FftTw& tw0, cf* lds) {
  FftTw tw; tw.c1 = cf{launderf(tw0.c1.x), launderf(tw0.c1.y)}; tw.c2 = cf{launderf(tw0.c2.x), launderf(tw0.c2.y)}; tw.c4 = tw0.c4; tw.c5 = tw0.c5;
  fwd_p1(x, t, tw, lds); __syncthreads();
  fwd_p2(x, t, tw, lds); __syncthreads();
  fwd_p3(x, t, lds); __syncthreads();
}
HD void fft_inv(cf* x, int t, const FftTw& tw0, cf* lds) {
  FftTw tw; tw.c2 = cf{launderf(tw0.c2.x), launderf(tw0.c2.y)}; tw.c4 = cf{launderf(tw0.c4.x), launderf(tw0.c4.y)}; tw.c5 = cf{launderf(tw0.c5.x), launderf(tw0.c5.y)}; tw.c1 = tw0.c1;
  inv_p3(x, t, tw, lds); __syncthreads();
  inv_p2(x, t, tw, lds); __syncthreads();
  inv_p1(x, t, lds); __syncthreads();
}
HD cf cispi(float a) { float s, c; sincospif(a, &s, &c); return cf{c, s}; }

__device__ __forceinline__ void gemm_tile(const bf16* __restrict__ A, int lda, const bf16* __restrict__ Bt, int ldb, int K, char* smem,
                                          f32x4 (&acc)[4][4]) {
  const int tid = launder((int)threadIdx.x & 255), lane = tid & 63, w = tid >> 6, wr = w >> 1, wc = w & 1, l15 = lane & 15, quad = lane >> 4;
#pragma unroll
  for (int m = 0; m < 4; ++m)
#pragma unroll
    for (int n = 0; n < 4; ++n) acc[m][n] = f32x4{0.f, 0.f, 0.f, 0.f};
  uint4 ra_0, ra_1, ra_2, ra_3, rb_0, rb_1, rb_2, rb_3;
  const int nk = K >> 6;
  const int r0 = tid >> 3, ch = tid & 7;
  const int goa = r0 * lda + ch * 8, gob = r0 * ldb + ch * 8;
  const int so0 = r0 * 128 + ((ch ^ (r0 & 7)) << 4);
#define GT_LOAD(kt) do { const bf16* ap = A + (kt) * 64 + goa; const bf16* bp = Bt + (kt) * 64 + gob; \
    ra_0 = *(const uint4*)(ap); rb_0 = *(const uint4*)(bp); ra_1 = *(const uint4*)(ap + 32 * lda); rb_1 = *(const uint4*)(bp + 32 * ldb); \
    ra_2 = *(const uint4*)(ap + 64 * lda); rb_2 = *(const uint4*)(bp + 64 * ldb); ra_3 = *(const uint4*)(ap + 96 * lda); rb_3 = *(const uint4*)(bp + 96 * ldb); } while (0)
#define GT_STORE(dstp) do { *(uint4*)((dstp) + so0) = ra_0; *(uint4*)((dstp) + 16384 + so0) = rb_0; *(uint4*)((dstp) + so0 + 4096) = ra_1; *(uint4*)((dstp) + 16384 + so0 + 4096) = rb_1; \
    *(uint4*)((dstp) + so0 + 8192) = ra_2; *(uint4*)((dstp) + 16384 + so0 + 8192) = rb_2; *(uint4*)((dstp) + so0 + 12288) = ra_3; *(uint4*)((dstp) + 16384 + so0 + 12288) = rb_3; } while (0)
  GT_LOAD(0);
  GT_STORE(smem);
  HSYNC();
  for (int kt = 0; kt < nk; ++kt) {
    char* cur = smem + (kt & 1) * 32768;
    char* nxt = smem + ((kt + 1) & 1) * 32768;
    if (kt + 1 < nk) { GT_LOAD(kt + 1); }
#pragma unroll
    for (int kk = 0; kk < 2; ++kk) {
      bf16x8 af[4], bfr[4];
#pragma unroll
      for (int m = 0; m < 4; ++m) {
        int r = wr * 64 + m * 16 + l15;
        af[m] = *(const bf16x8*)(cur + r * 128 + (((kk * 4 + quad) ^ (r & 7)) << 4));
      }
#pragma unroll
      for (int n = 0; n < 4; ++n) {
        int r = wc * 64 + n * 16 + l15;
        bfr[n] = *(const bf16x8*)(cur + 16384 + r * 128 + (((kk * 4 + quad) ^ (r & 7)) << 4));
      }
#pragma unroll
      for (int m = 0; m < 4; ++m)
#pragma unroll
        for (int n = 0; n < 4; ++n) acc[m][n] = __builtin_amdgcn_mfma_f32_16x16x32_bf16(af[m], bfr[n], acc[m][n], 0, 0, 0);
    }
    if (kt + 1 < nk) { GT_STORE(nxt); }
    HSYNC();
  }
#undef GT_LOAD
#undef GT_STORE
}

__device__ __forceinline__ int g2_lds_byte(int r, int c) {
  int st = (r >> 4) * 2 + (c >> 5), ob = (r & 15) * 64 + (c & 31) * 2;
  return st * 1024 + (ob ^ (((ob >> 9) & 1) << 5));
}
__device__ __forceinline__ void g2_stage_rc(int b, int& R, int& C) {
  int st = b >> 10, sb = b & 1023, swz = sb ^ (((sb >> 9) & 1) << 5);
  R = (st >> 1) * 16 + swz / 64;
  C = (st & 1) * 32 + (swz % 64) / 2;
}
template <int NKT, int LDA, int LDB>
__device__ __forceinline__ void gemm256g(const bf16* __restrict__ Ab, const bf16* __restrict__ Bb, char* shm, f32x4 (&acc)[8][4]) {
  constexpr int TILE_B = 256 * 64 * 2, STAGE_B = 2 * TILE_B, GL = 4, nt = NKT;
  const int tid = launder((int)threadIdx.x), wid = tid >> 6, lane = tid & 63, wr = wid >> 2, wc = wid & 3, fr = lane & 15, fq = lane >> 4;
  int sOffA[GL], sOffB[GL];
#pragma unroll
  for (int i = 0; i < GL; ++i) { int R, C; g2_stage_rc(wid * 1024 + i * 8192 + lane * 16, R, C); sOffA[i] = R * LDA + C; sOffB[i] = R * LDB + C; }
#define G2_STAGE(buf, kt) do { _Pragma("unroll") for (int i = 0; i < GL; ++i) { \
    __builtin_amdgcn_global_load_lds((const unsigned*)(Ab + sOffA[i] + (kt) * 64), (unsigned*)(shm + (buf) * STAGE_B + wid * 1024 + i * 8192), 16, 0, 0); \
    __builtin_amdgcn_global_load_lds((const unsigned*)(Bb + sOffB[i] + (kt) * 64), (unsigned*)(shm + (buf) * STAGE_B + TILE_B + wid * 1024 + i * 8192), 16, 0, 0); } } while (0)
#pragma unroll
  for (int m = 0; m < 8; ++m)
#pragma unroll
    for (int n = 0; n < 4; ++n) acc[m][n] = f32x4{0.f, 0.f, 0.f, 0.f};
  G2_STAGE(0, 0);
  asm volatile("s_waitcnt vmcnt(0)" ::: "memory");
  __syncthreads();
  for (int t = 0; t < nt; ++t) {
    const int cur = t & 1;
    if (t + 1 < nt) G2_STAGE(cur ^ 1, t + 1);
    const char* sa = shm + cur * STAGE_B;
    const char* sb = sa + TILE_B;
#pragma unroll
    for (int ks = 0; ks < 2; ++ks) {
      bf16x8 At[8], Bf[4];
#pragma unroll
      for (int m = 0; m < 8; ++m) At[m] = *(const bf16x8*)(sa + g2_lds_byte(wr * 128 + m * 16 + fr, ks * 32 + fq * 8));
#pragma unroll
      for (int n = 0; n < 4; ++n) Bf[n] = *(const bf16x8*)(sb + g2_lds_byte(wc * 64 + n * 16 + fr, ks * 32 + fq * 8));
#pragma unroll
      for (int m = 0; m < 8; ++m)
#pragma unroll
        for (int n = 0; n < 4; ++n) acc[m][n] = __builtin_amdgcn_mfma_f32_16x16x32_bf16(At[m], Bf[n], acc[m][n], 0, 0, 0);
      __builtin_amdgcn_sched_barrier(0);
    }
    asm volatile("s_waitcnt vmcnt(0)" ::: "memory");
    __syncthreads();
  }
#undef G2_STAGE
}
__device__ __forceinline__ void gemm256(const bf16* __restrict__ Ab, const bf16* __restrict__ Bb, char* shm, f32x4 (&acc)[8][4]) {
  gemm256g<DM / 64, DM, DM>(Ab, Bb, shm, acc);
}
__device__ __forceinline__ void gemm256_8p(const bf16* __restrict__ A, const bf16* __restrict__ Bt, char* shmc, f32x4 (&acc)[2][2][4][2]) {
  constexpr int K = DM, BK = 64, HALF = 128, HT = HALF * BK;
  bf16* shm = (bf16*)shmc;
#define SA(b,h) (shm+((b)*2+(h))*HT)
#define SB(b,h) (shm+(4+(b)*2+(h))*HT)
#define STAGE(P_,BASE,br,kt) do{long _g=(long)(br)*K+(long)(kt)*BK; \
    for(int _i=0;_i<2;++_i){int _b=tid*16+_i*8192;int _r,_c;g2_stage_rc(_b,_r,_c); \
      __builtin_amdgcn_global_load_lds((const unsigned*)(BASE+_g+(long)_r*K+_c), \
        (unsigned*)((char*)(P_)+_b),16,0,0);}}while(0)
#define LDA(dst,b,h) for(int m=0;m<4;++m)for(int k=0;k<2;++k) \
    dst[m][k]=*reinterpret_cast<const bf16x8*>((char*)SA(b,h)+g2_lds_byte(wr*64+m*16+fr,k*32+fq*8))
#define LDB(dst,b,h) for(int n=0;n<2;++n)for(int k=0;k<2;++k) \
    dst[n][k]=*reinterpret_cast<const bf16x8*>((char*)SB(b,h)+g2_lds_byte(wc*32+n*16+fr,k*32+fq*8))
#define MMA(ai,bj,At_,Bt_) do{__builtin_amdgcn_s_setprio(1); \
    for(int m=0;m<4;++m)for(int n=0;n<2;++n)for(int k=0;k<2;++k) \
      acc[ai][bj][m][n]=__builtin_amdgcn_mfma_f32_16x16x32_bf16(At_[m][k],Bt_[n][k],acc[ai][bj][m][n],0,0,0); \
    __builtin_amdgcn_s_setprio(0);}while(0)
#define WAIT_V(n) asm volatile("s_waitcnt vmcnt(" #n ")":::"memory")
#define WAIT_L(n) asm volatile("s_waitcnt lgkmcnt(" #n ")":::"memory")
#define BAR __builtin_amdgcn_s_barrier()
#define SCHED __builtin_amdgcn_sched_barrier(0)
  const int tid = launder((int)threadIdx.x);
  const int wid = tid >> 6, lane = tid & 63, wr = wid >> 2, wc = wid & 3, fr = lane & 15, fq = lane >> 4;
#pragma unroll
  for (int a = 0; a < 2; ++a)
#pragma unroll
    for (int b = 0; b < 2; ++b)
#pragma unroll
      for (int m = 0; m < 4; ++m)
#pragma unroll
        for (int n = 0; n < 2; ++n) acc[a][b][m][n] = f32x4{0.f, 0.f, 0.f, 0.f};
  bf16x8 At[4][2], B0[2][2], B1[2][2];
  constexpr int nt = K / BK;
  STAGE(SB(0,0),Bt,0,0); STAGE(SA(0,0),A,0,0);
  STAGE(SB(0,1),Bt,HALF,0); STAGE(SA(0,1),A,HALF,0);
  if(wr==1)BAR;
  WAIT_V(4); BAR;
  STAGE(SB(1,0),Bt,0,1); STAGE(SA(1,0),A,0,1); STAGE(SB(1,1),Bt,HALF,1);
  WAIT_V(6); BAR;
  for(int t=0;t<nt-2;t+=2){
    LDB(B0,0,0); SCHED; LDA(At,0,0); STAGE(SA(1,1),A,HALF,t+1);
    WAIT_L(8); BAR; WAIT_L(0); MMA(0,0,At,B0); BAR; SCHED;
    LDB(B1,0,1); STAGE(SB(0,0),Bt,0,t+2);
    BAR; WAIT_L(0); MMA(0,1,At,B1); BAR;
    LDA(At,0,1); STAGE(SA(0,0),A,0,t+2);
    BAR; WAIT_L(0); MMA(1,0,At,B0); BAR; SCHED;
    STAGE(SB(0,1),Bt,HALF,t+2);
    WAIT_V(6); BAR; MMA(1,1,At,B1); BAR;
    LDB(B0,1,0); SCHED; LDA(At,1,0); STAGE(SA(0,1),A,HALF,t+2);
    WAIT_L(8); BAR; WAIT_L(0); MMA(0,0,At,B0); BAR; SCHED;
    LDB(B1,1,1); STAGE(SB(1,0),Bt,0,t+3);
    BAR; WAIT_L(0); MMA(0,1,At,B1); BAR;
    LDA(At,1,1); STAGE(SA(1,0),A,0,t+3);
    BAR; WAIT_L(0); MMA(1,0,At,B0); BAR; SCHED;
    STAGE(SB(1,1),Bt,HALF,t+3);
    WAIT_V(6); BAR; MMA(1,1,At,B1); BAR;
  }
  { LDB(B0,0,0); LDA(At,0,0); STAGE(SA(1,1),A,HALF,nt-1);
    BAR; WAIT_L(0); MMA(0,0,At,B0); BAR;
    LDB(B1,0,1); BAR; WAIT_L(0); MMA(0,1,At,B1); BAR;
    LDA(At,0,1); WAIT_V(4); BAR; WAIT_L(0); MMA(1,0,At,B0); MMA(1,1,At,B1); BAR; }
  { LDB(B0,1,0); LDA(At,1,0); WAIT_V(2); BAR; WAIT_L(0); MMA(0,0,At,B0); BAR;
    LDB(B1,1,1); WAIT_V(0); BAR; WAIT_L(0); MMA(0,1,At,B1); BAR;
    LDA(At,1,1); BAR; WAIT_L(0); MMA(1,0,At,B0); MMA(1,1,At,B1); BAR; }
  if(wr==0)BAR;
#undef SA
#undef SB
#undef STAGE
#undef LDA
#undef LDB
#undef MMA
#undef WAIT_V
#undef WAIT_L
#undef BAR
#undef SCHED
}

__device__ __forceinline__ void g2_tile(int L, int nM, int nN, int& pm, int& pn) {
  const int nwg = nM * nN;
  int wgid = L;
  { const int q = nwg / 8, r = nwg % 8, xcd = wgid % 8, off = wgid / 8; wgid = (xcd < r ? xcd * (q + 1) : r * (q + 1) + (xcd - r) * q) + off; }
  const int nig = 8 * nN, gid = wgid / nig, fm = gid * 8, gsz = (nM - fm) < 8 ? (nM - fm) : 8;
  pm = fm + ((wgid % nig) % gsz); pn = (wgid % nig) / gsz;
}

__device__ void transpose_tile(const float* __restrict__ src, int ldsrc, int k0, int srccol0, bf16* __restrict__ dst, int lddst, int dstrow0,
                               const float* __restrict__ gk, bool zero, char* smem) {
  float* tl = (float*)smem;
  const int tid = launder((int)threadIdx.x & 255);
  {
    const int kq = tid >> 6, nn = tid & 63;
    float v[16], g[16];
    const float* sp = src + (size_t)(k0 + kq) * ldsrc + srccol0 + nn;
#pragma unroll
    for (int i = 0; i < 16; ++i) v[i] = zero ? 0.f : sp[(size_t)(4 * i) * ldsrc];
#pragma unroll
    for (int i = 0; i < 16; ++i) g[i] = gk ? gk[k0 + kq + 4 * i] : 1.f;
#pragma unroll
    for (int i = 0; i < 16; ++i) tl[(kq + 4 * i) * 65 + nn] = v[i] * g[i];
  }
  HSYNC();
#pragma unroll
  for (int i = 0; i < 2; ++i) {
    int id = tid + 256 * i, nn = id >> 3, kc = id & 7;
    uint4 o;
    o.x = pack2(tl[(kc * 8 + 0) * 65 + nn], tl[(kc * 8 + 1) * 65 + nn]);
    o.y = pack2(tl[(kc * 8 + 2) * 65 + nn], tl[(kc * 8 + 3) * 65 + nn]);
    o.z = pack2(tl[(kc * 8 + 4) * 65 + nn], tl[(kc * 8 + 5) * 65 + nn]);
    o.w = pack2(tl[(kc * 8 + 6) * 65 + nn], tl[(kc * 8 + 7) * 65 + nn]);
    *(uint4*)(dst + (size_t)(dstrow0 + nn) * lddst + k0 + kc * 8) = o;
  }
  HSYNC();
}
__device__ void win_transpose_task(const Params& P, int l, int task, char* smem) {
  int nt = task >> 5, kt = task & 31;
  int n0 = nt * 64;
  int srccol; bool zero = false;
  if (n0 < 1856) srccol = n0;
  else if (n0 < 2880) srccol = 4928 + (n0 - 1856);
  else if (n0 < 2944 || n0 >= 6016) { srccol = 0; zero = true; }
  else srccol = 1856 + (n0 - 2944);
  transpose_tile(P.w_in + (size_t)l * DM * NIN, NIN, kt * 64, srccol, P.wT_in, DM, n0, nullptr, zero, smem);
}
__device__ void modulation_task(const Params& P, int task, char* smem) {
  float* s = (float*)smem;
  float* red = s + 5 * 2048;
  const int tid = launder((int)threadIdx.x & 255);
  int l = task / 96, cgp = task % 96;
  for (int i = tid; i < 5 * 2048; i += 256) {
    int v = i >> 11, k = i & 2047;
    float cv = (v < 4) ? P.c[v * 2048 + k] : P.c_ctx[k];
    s[i] = cv / (1.f + expf(-cv));
  }
  HSYNC();
  int kg = tid >> 6, cj = tid & 63, col = cgp * 64 + cj;
  float acc[5] = {0.f, 0.f, 0.f, 0.f, 0.f};
  const float* wp = P.ada_w + ((size_t)l * 2048 + kg * 512) * 6144 + col;
  const float* sp = s + kg * 512;
#pragma unroll 8
  for (int k = 0; k < 512; ++k) {
    float wv = wp[(size_t)k * 6144];
#pragma unroll
    for (int v = 0; v < 5; ++v) acc[v] += sp[v * 2048 + k] * wv;
  }
#pragma unroll
  for (int v = 0; v < 5; ++v) red[(kg * 5 + v) * 64 + cj] = acc[v];
  HSYNC();
  for (int i = tid; i < 320; i += 256) {
    int v = i >> 6, c2 = i & 63;
    float a = red[(0 * 5 + v) * 64 + c2] + red[(1 * 5 + v) * 64 + c2] + red[(2 * 5 + v) * 64 + c2] + red[(3 * 5 + v) * 64 + c2];
    int cc = cgp * 64 + c2;
    P.mod[(size_t)(l * 5 + v) * 6144 + cc] = a + P.ada_b[l * 6144 + cc];
  }
  HSYNC();
}
__device__ void h2_task(const Params& P, int task, char* smem) {
  float* zf = (float*)smem;
  float* h1 = zf + 4 * 36;
  const int tid = launder((int)threadIdx.x & 255), pos = tid >> 6, j = tid & 63;
  int which, n0;
  if (task < 1024) { which = 0; n0 = task * 4; }
  else if (task < 2048) { which = 1; n0 = (task - 1024) * 4; }
  else { which = 2; n0 = (task - 2048) * 4; }
  const int Lc = (which == 2) ? 256 : 4096;
  const int l = (which == 1) ? 1 : 0;
  const int n = n0 + pos;
  if (j < 33) {
    float v;
    if (j == 0) v = (float)n / (float)(Lc - 1);
    else {
      int k = (j - 1) & 15;
      float f = 1e-4f + (float)k * ((15.f - 1e-4f) / 15.f);
      float wpos = (6.283185307179586f * (float)n) / (float)Lc;
      float a = f * wpos;
      v = (j <= 16) ? cosf(a) : -sinf(a);
    }
    zf[pos * 36 + j] = v;
  }
  HSYNC();
  float fr = P.filt_freq[l * 64 + j];
  float a = P.filt_b1[l * 64 + j];
#pragma unroll
  for (int i = 0; i < 33; ++i) a += zf[pos * 36 + i] * P.filt_w1[(l * 33 + i) * 64 + j];
  h1[pos * 64 + j] = sinf(fr * a);
  HSYNC();
  float a2 = P.filt_b2[l * 64 + j];
#pragma unroll 8
  for (int i = 0; i < 64; ++i) a2 += h1[pos * 64 + i] * P.filt_w2[(l * 64 + i) * 64 + j];
  float hv = sinf(fr * a2);
  if (which == 2) P.h2cT[j * 256 + n] = hv;
  else P.h2T[((size_t)l * 64 + j) * 4096 + n] = f2bf(hv);
  HSYNC();
}
__device__ void rope_table_task(const Params& P) {
  for (int i = launder((int)threadIdx.x & 255); i < 64 * 16; i += 256) {
    int pos = i >> 4, f = i & 15;
    float inv = powf(10000.f, -(float)f / 16.f);
    float ang = (float)pos * inv;
    P.rope[2 * i] = cosf(ang);
    P.rope[2 * i + 1] = sinf(ang);
  }
}

__device__ __forceinline__ void prenorm_store(const Params& P, const float4* v, int row, int l, int mv, int lane) {
  float ss = 0.f;
#pragma unroll
  for (int i = 0; i < 8; ++i) ss += v[i].x * v[i].x + v[i].y * v[i].y + v[i].z * v[i].z + v[i].w * v[i].w;
  ss = wave_sum(ss);
  float r = rsqrtf(ss * (1.f / 2048.f) + EPSN);
  const float* md = P.mod + (size_t)(l * 5 + mv) * 6144;
#pragma unroll
  for (int i = 0; i < 8; ++i) {
    int idx = (i * 64 + lane) * 4;
    float4 g = *(const float4*)(P.pre_g + l * 2048 + idx);
    float4 sh = *(const float4*)(md + idx);
    float4 sc = *(const float4*)(md + 2048 + idx);
    float o0 = v[i].x * r * g.x * (1.f + sc.x) + sh.x;
    float o1 = v[i].y * r * g.y * (1.f + sc.y) + sh.y;
    float o2 = v[i].z * r * g.z * (1.f + sc.z) + sh.z;
    float o3 = v[i].w * r * g.w * (1.f + sc.w) + sh.w;
    uint2 o; o.x = pack2(o0, o1); o.y = pack2(o2, o3);
    *(uint2*)(P.xh + (size_t)row * 2048 + idx) = o;
  }
}
__device__ void phase_prenorm0(const Params& P) {
  const int lane = launder((int)threadIdx.x & 255) & 63, wv = launder((int)threadIdx.x & 255) >> 6;
  for (int row = VBID * 4 + wv; row < TT; row += VGRID * 4) {
    const float* src = (row < TX) ? (P.x + (size_t)row * 2048) : (P.ctx + (size_t)(row - TX) * 2048);
    int mv = (row < TX) ? (row >> 12) : 4;
    float4 v[8];
#pragma unroll
    for (int i = 0; i < 8; ++i) v[i] = *(const float4*)(src + (i * 64 + lane) * 4);
    prenorm_store(P, v, row, 0, mv, lane);
  }
}
__device__ void phase_post(const Params& P, int l) {
  const int lane = launder((int)threadIdx.x & 255) & 63, wv = launder((int)threadIdx.x & 255) >> 6;
  const int nrows = (l == 0) ? TT : TX;
  for (int row = VBID * 4 + wv; row < nrows; row += VGRID * 4) {
    const bool isx = row < TX;
    int mv = isx ? (row >> 12) : 4;
    const float* zr = P.z + (size_t)row * 2048;
    const float* xo = (l == 0) ? (isx ? P.x + (size_t)row * 2048 : P.ctx + (size_t)(row - TX) * 2048) : (P.out + (size_t)row * 2048);
    float* xn = isx ? (P.out + (size_t)row * 2048) : (P.ctx1 + (size_t)(row - TX) * 2048);
    float4 zv[8];
    float ss = 0.f;
#pragma unroll
    for (int i = 0; i < 8; ++i) {
      zv[i] = *(const float4*)(zr + (i * 64 + lane) * 4);
      ss += zv[i].x * zv[i].x + zv[i].y * zv[i].y + zv[i].z * zv[i].z + zv[i].w * zv[i].w;
    }
    ss = wave_sum(ss);
    float r = rsqrtf(ss * (1.f / 2048.f) + EPSN);
    const float* gt = P.mod + (size_t)(l * 5 + mv) * 6144 + 4096;
#pragma unroll
    for (int i = 0; i < 8; ++i) {
      int idx = (i * 64 + lane) * 4;
      float4 xv = *(const float4*)(xo + idx);
      float4 g = *(const float4*)(gt + idx);
      float4 pg = *(const float4*)(P.post_g + l * 2048 + idx);
      zv[i].x = xv.x + g.x * zv[i].x * r * pg.x;
      zv[i].y = xv.y + g.y * zv[i].y * r * pg.y;
      zv[i].z = xv.z + g.z * zv[i].z * r * pg.z;
      zv[i].w = xv.w + g.w * zv[i].w * r * pg.w;
      *(float4*)(xn + idx) = zv[i];
    }
    if (l == 0) prenorm_store(P, zv, row, 1, mv, lane);
  }
  if (l == 0) {
  }
}

__device__ void gemm_in_task(const Params& P, int l, int mt, int nt, char* smem) {
  f32x4 acc[2][2][4][2];
  const int row0 = mt * 256, col0 = nt * 256;
  gemm256_8p(P.xh + (size_t)row0 * DM, P.wT_in + (size_t)col0 * DM, smem, acc);
  const int tid = launder((int)threadIdx.x), lane = tid & 63, w = tid >> 6, wr = w >> 2, wc = w & 3, l15 = lane & 15, quad = lane >> 4;
  const bool isx = row0 < TX;
#pragma unroll
  for (int ai = 0; ai < 2; ++ai)
#pragma unroll
    for (int bj = 0; bj < 2; ++bj) {
      const int rowb = row0 + ai * 128 + wr * 64;
      const int colc = col0 + bj * 128 + wc * 32;
      if (colc < NPA) {
        if (colc >= 768 && colc < 832) {
          const int axis = (colc - 768) >> 5;
#pragma unroll
          for (int m = 0; m < 4; ++m)
#pragma unroll
            for (int j = 0; j < 4; ++j) {
              int row = rowb + m * 16 + quad * 4 + j;
              float v0 = acc[ai][bj][m][0][j], v1 = acc[ai][bj][m][1][j];
              int b, kk;
              if (isx) {
                int t = row & 4095; b = row >> 12; kk = 256 + t;
                int pos = axis ? (t & 63) : (t >> 6);
                float2 cs = *(const float2*)(P.rope + 2 * (pos * 16 + l15));
                float a0 = v0 * cs.x - v1 * cs.y, a1 = v1 * cs.x + v0 * cs.y;
                v0 = a0; v1 = a1;
              } else { int rc = row - TX; b = rc >> 8; kk = rc & 255; }
              bf16* dst = P.kr + ((size_t)b * LK + kk) * 64 + axis * 32 + l15;
              dst[0] = f2bf(v0); dst[16] = f2bf(v1);
            }
        } else {
#pragma unroll
          for (int m = 0; m < 4; ++m)
#pragma unroll
            for (int n = 0; n < 2; ++n)
#pragma unroll
              for (int j = 0; j < 4; ++j) {
                int row = rowb + m * 16 + quad * 4 + j, col = colc + n * 16 + l15;
                P.pa[(size_t)row * NPA + col] = f2bf(acc[ai][bj][m][n][j]);
              }
        }
      } else if (colc < NPA + NHYC) {
        const int hc0 = colc - NPA;
        if (isx) {
          const int b = row0 >> 12, t0 = (rowb & 4095);
#pragma unroll
          for (int m = 0; m < 4; ++m)
#pragma unroll
            for (int n = 0; n < 2; ++n) {
              int hc = hc0 + n * 16 + l15, t = t0 + m * 16 + quad * 4;
              uint2 o; o.x = pack2(acc[ai][bj][m][n][0], acc[ai][bj][m][n][1]); o.y = pack2(acc[ai][bj][m][n][2], acc[ai][bj][m][n][3]);
              *(uint2*)(P.pT + ((size_t)b * NHYC + hc) * 4096 + t) = o;
            }
        } else if (l == 0) {
          const int rc0 = rowb - TX, b = rc0 >> 8, t0 = rc0 & 255;
#pragma unroll
          for (int m = 0; m < 4; ++m)
#pragma unroll
            for (int n = 0; n < 2; ++n) {
              int hc = hc0 + n * 16 + l15, t = t0 + m * 16 + quad * 4;
              uint2 o; o.x = pack2(acc[ai][bj][m][n][0], acc[ai][bj][m][n][1]); o.y = pack2(acc[ai][bj][m][n][2], acc[ai][bj][m][n][3]);
              *(uint2*)(P.pchy + ((size_t)b * NHYC + hc) * 256 + t) = o;
            }
        }
      }
    }
  __syncthreads();
}
__device__ void phase_gemm_in(const Params& P, int l, char* smem) {
  const int nM = 68, nN = 24;
  for (int L = blockIdx.x; L < nM * nN; L += gridDim.x) {
    int mt, nt;
    g2_tile(L, nM, nN, mt, nt);
    if (l == 1 && mt >= 64 && nt >= 12) continue;
    gemm_in_task(P, l, mt, nt, smem);
  }
}

__device__ void q_gemm_task(const Params& P, int l, int mt, int nt, char* smem) {
  float* rs = (float*)(smem + 131072);
  const int tid = launder((int)threadIdx.x), lane = tid & 63, w = tid >> 6, wr = w >> 2, wc = w & 3, l15 = lane & 15, quad = lane >> 4;
  const int row0 = mt * 256, col0 = nt * 256;
#pragma unroll 1
  for (int g = 0; g < 2; ++g) {
    uint4 v[16];
    const bf16* pb = P.pa + (size_t)(row0 + w * 32 + g * 16) * NPA + lane * 8;
#pragma unroll
    for (int e = 0; e < 16; ++e) v[e] = *(const uint4*)(pb + (size_t)e * NPA);
    float ss[16];
#pragma unroll
    for (int e = 0; e < 16; ++e) {
      unsigned uu[4] = {v[e].x, v[e].y, v[e].z, v[e].w};
      float a = 0.f;
#pragma unroll
      for (int q = 0; q < 4; ++q) { float x0 = __uint_as_float(uu[q] << 16), x1 = __uint_as_float(uu[q] & 0xffff0000u); a += x0 * x0 + x1 * x1; }
      ss[e] = a;
    }
#pragma unroll
    for (int e = 0; e < 16; ++e) { float t2 = wave_sum(ss[e]); if (lane == 0) rs[w * 32 + g * 16 + e] = rsqrtf(t2 * (1.f / 512.f) + EPSN) * QSCALE; }
  }
  __syncthreads();
  f32x4 acc[8][4];
  gemm256g<8, NPA, 512>(P.pa + (size_t)row0 * NPA, P.wT_uq + (size_t)l * QW * 512 + (size_t)col0 * 512, smem, acc);
  const int rowbase = row0 + wr * 128, colbase = col0 + wc * 64;
  const bool isx = row0 < TX;
  const bool ropet = isx && (((colbase >> 6) % 3) == 2);
#pragma unroll
  for (int m = 0; m < 8; ++m)
#pragma unroll
    for (int j = 0; j < 4; ++j) {
      int row = rowbase + m * 16 + quad * 4 + j;
      float sc = rs[row - row0];
      float v0 = acc[m][0][j] * sc, v1 = acc[m][1][j] * sc, v2 = acc[m][2][j] * sc, v3 = acc[m][3][j] * sc;
      if (ropet) {
        int t = row & 4095;
        float2 cs0 = *(const float2*)(P.rope + 2 * ((t >> 6) * 16 + l15));
        float2 cs1 = *(const float2*)(P.rope + 2 * ((t & 63) * 16 + l15));
        float a0 = v0 * cs0.x - v1 * cs0.y, a1 = v1 * cs0.x + v0 * cs0.y;
        float a2 = v2 * cs1.x - v3 * cs1.y, a3 = v3 * cs1.x + v2 * cs1.y;
        v0 = a0; v1 = a1; v2 = a2; v3 = a3;
      }
      bf16* dst = P.qbuf + (size_t)row * QW + colbase + l15;
      dst[0] = f2bf(v0); dst[16] = f2bf(v1); dst[32] = f2bf(v2); dst[48] = f2bf(v3);
    }
  __syncthreads();
}
__device__ void kv_gemm_task(const Params& P, int l, int mt, int h, char* smem) {
  float* rs = (float*)(smem + 131072);
  const int tid = launder((int)threadIdx.x), lane = tid & 63, w = tid >> 6, wr = w >> 2, wc = w & 3, l15 = lane & 15, quad = lane >> 4;
  const int row0 = mt * 256;
#pragma unroll 1
  for (int g = 0; g < 2; ++g) {
    uint2 v[16];
    const bf16* pb = P.pa + (size_t)(row0 + w * 32 + g * 16) * NPA + 512 + lane * 4;
#pragma unroll
    for (int e = 0; e < 16; ++e) v[e] = *(const uint2*)(pb + (size_t)e * NPA);
    float ss[16];
#pragma unroll
    for (int e = 0; e < 16; ++e) {
      float a0 = __uint_as_float(v[e].x << 16), a1 = __uint_as_float(v[e].x & 0xffff0000u), a2 = __uint_as_float(v[e].y << 16), a3 = __uint_as_float(v[e].y & 0xffff0000u);
      ss[e] = a0 * a0 + a1 * a1 + a2 * a2 + a3 * a3;
    }
#pragma unroll
    for (int e = 0; e < 16; ++e) { float t2 = wave_sum(ss[e]); if (lane == 0) rs[w * 32 + g * 16 + e] = rsqrtf(t2 * (1.f / 256.f) + EPSN); }
  }
  __syncthreads();
  f32x4 acc[8][4];
  gemm256g<4, NPA, 256>(P.pa + (size_t)row0 * NPA + 512, P.wT_ukv + (size_t)l * 2048 * 256 + (size_t)h * 256 * 256, smem, acc);
  const int rowbase = row0 + wr * 128;
  int b, kk0;
  if (row0 < TX) { b = row0 >> 12; kk0 = 256 + (rowbase & 4095); }
  else { int rc = rowbase - TX; b = rc >> 8; kk0 = rc & 255; }
  if (wc < 2) {
#pragma unroll
    for (int m = 0; m < 8; ++m)
#pragma unroll
      for (int j = 0; j < 4; ++j) {
        int rl = m * 16 + quad * 4 + j;
        float sc = rs[wr * 128 + rl];
        bf16* dst = P.Kn + (((size_t)b * 8 + h) * LK + kk0 + rl) * 128 + wc * 64 + l15;
#pragma unroll
        for (int n = 0; n < 4; ++n) dst[n * 16] = f2bf(acc[m][n][j] * sc);
      }
  } else {
#pragma unroll
    for (int m = 0; m < 8; ++m) {
      int rl = m * 16 + quad * 4;
      float s0 = rs[wr * 128 + rl], s1 = rs[wr * 128 + rl + 1], s2 = rs[wr * 128 + rl + 2], s3 = rs[wr * 128 + rl + 3];
#pragma unroll
      for (int n = 0; n < 4; ++n) {
        int d = (wc - 2) * 64 + n * 16 + l15;
        uint2 o; o.x = pack2(acc[m][n][0] * s0, acc[m][n][1] * s1); o.y = pack2(acc[m][n][2] * s2, acc[m][n][3] * s3);
        *(uint2*)(P.vT + (((size_t)b * 8 + h) * 128 + d) * LK + kk0 + rl) = o;
      }
    }
  }
  __syncthreads();
}

__device__ __forceinline__ float conv3(const bf16* __restrict__ rowp, int n, float w0, float w1, float w2, float bb) {
  float a = bb + w1 * bf2f(rowp[n]);
  if (n > 0) a += w0 * bf2f(rowp[n - 1]);
  if (n < 4095) a += w2 * bf2f(rowp[n + 1]);
  return a;
}
__device__ __forceinline__ float convl(const bf16* rowp, int n, float w0, float w1, float w2, float bb) {
  float pm = bf2f(rowp[n > 0 ? n - 1 : 0]), pc = bf2f(rowp[n]), pp = bf2f(rowp[n < 4095 ? n + 1 : 4095]);
  return bb + w1 * pc + ((n > 0) ? w0 : 0.f) * pm + ((n < 4095) ? w2 : 0.f) * pp;
}
__device__ void hyena_x_task(const Params& P, int l, int c, char* smem) {
  cf* lds = (cf*)smem;
  cf* est = (cf*)(smem + 34816);
  float* hbx = (float*)(smem + 34816);
  float* w3s = (float*)(smem + 34816 + 32768);
  const int t = launder((int)threadIdx.x & 255);
  FftTw tw;
  tw.c1 = cispi(-(float)t / 2048.f);
  tw.c2 = cispi(-(float)(t & 15) / 128.f);
  tw.c4 = cispi(-(float)((t & 15) * (t >> 4)) / 2048.f);
  tw.c5 = cispi(-(float)(t >> 4) / 128.f);
  const cf c8 = cispi(-(float)t / 4096.f);
  const cf w32 = cf{0.98078528040323043f, -0.19509032201612825f};
  if (t < 128) w3s[t] = P.filt_w3[((size_t)l * 64 + (t & 63)) * 2048 + (t >> 6) * 1024 + c];
  __syncthreads();
  cf* kfe = (cf*)P.kfg + (size_t)VBID * 8192;
  cf* kfo = kfe + 4096;
  {
    cf ke[16];
    float af[16], ab[16];
    float* hfx = (float*)(smem + 34816);
    float* hbx2 = (float*)(smem + 34816 + 16384);
    {
#pragma unroll
      for (int j = 0; j < 16; ++j) { af[j] = 0.f; ab[j] = 0.f; }
      const bf16* h2p = P.h2T + (size_t)l * 64 * 4096;
#pragma unroll 2
      for (int i = 0; i < 64; ++i) {
        const float wf = w3s[i], wb = w3s[64 + i];
        const uint4* hp = (const uint4*)(h2p + i * 4096 + 16 * t);
        const uint4 q0 = hp[0], q1 = hp[1];
        float4 h0, h1, h2v, h3;
        h0.x = __uint_as_float(q0.x << 16); h0.y = __uint_as_float(q0.x & 0xffff0000u); h0.z = __uint_as_float(q0.y << 16); h0.w = __uint_as_float(q0.y & 0xffff0000u);
        h1.x = __uint_as_float(q0.z << 16); h1.y = __uint_as_float(q0.z & 0xffff0000u); h1.z = __uint_as_float(q0.w << 16); h1.w = __uint_as_float(q0.w & 0xffff0000u);
        h2v.x = __uint_as_float(q1.x << 16); h2v.y = __uint_as_float(q1.x & 0xffff0000u); h2v.z = __uint_as_float(q1.y << 16); h2v.w = __uint_as_float(q1.y & 0xffff0000u);
        h3.x = __uint_as_float(q1.z << 16); h3.y = __uint_as_float(q1.z & 0xffff0000u); h3.z = __uint_as_float(q1.w << 16); h3.w = __uint_as_float(q1.w & 0xffff0000u);
        af[0] += h0.x * wf; af[1] += h0.y * wf; af[2] += h0.z * wf; af[3] += h0.w * wf;
        af[4] += h1.x * wf; af[5] += h1.y * wf; af[6] += h1.z * wf; af[7] += h1.w * wf;
        af[8] += h2v.x * wf; af[9] += h2v.y * wf; af[10] += h2v.z * wf; af[11] += h2v.w * wf;
        af[12] += h3.x * wf; af[13] += h3.y * wf; af[14] += h3.z * wf; af[15] += h3.w * wf;
        ab[0] += h0.x * wb; ab[1] += h0.y * wb; ab[2] += h0.z * wb; ab[3] += h0.w * wb;
        ab[4] += h1.x * wb; ab[5] += h1.y * wb; ab[6] += h1.z * wb; ab[7] += h1.w * wb;
        ab[8] += h2v.x * wb; ab[9] += h2v.y * wb; ab[10] += h2v.z * wb; ab[11] += h2v.w * wb;
        ab[12] += h3.x * wb; ab[13] += h3.y * wb; ab[14] += h3.z * wb; ab[15] += h3.w * wb;
      }
      const float d0 = -15.350567286626973f, d1 = -3.0701134573253946f;
      const float adel = fabsf(d0 + (float)c * ((d1 - d0) / 1023.f));
#pragma unroll
      for (int j = 0; j < 16; ++j) {
        int n = 16 * t + j;
        float dec = expf(-((float)n * (1.f / 4095.f)) * adel);
        hfx[n] = af[j] * dec; hbx2[n] = ab[j] * dec;
      }
    }
    __syncthreads();
#pragma unroll
    for (int j = 0; j < 16; ++j) {
      int n = 256 * j + t;
      float k0 = hfx[n];
      float k1 = (n == 0) ? 0.f : hbx2[4096 - n];
      ke[j] = cf{k0 + k1, 0.f};
      af[j] = k0 - k1;
    }
    __syncthreads();
    fft_fwd(ke, t, tw, lds);
    { const int tl = launder(t); _Pragma("unroll") for (int r = 0; r < 16; ++r) kfe[r * 256 + tl] = ke[r]; }
    cf wn = cf{launderf(c8.x), launderf(c8.y)};
#pragma unroll
    for (int j = 0; j < 16; ++j) { ke[j] = cf{af[j] * wn.x, af[j] * wn.y}; wn = cmul(wn, w32); }
    fft_fwd(ke, t, tw, lds);
    { const int tl = launder(t); _Pragma("unroll") for (int r = 0; r < 16; ++r) kfo[r * 256 + tl] = ke[r]; }
  }
  const float cw10 = P.conv_w[(l * 3 + 0) * 3072 + 1024 + c], cw11 = P.conv_w[(l * 3 + 1) * 3072 + 1024 + c], cw12 = P.conv_w[(l * 3 + 2) * 3072 + 1024 + c];
  const float cwv0 = P.conv_w[(l * 3 + 0) * 3072 + 2048 + c], cwv1 = P.conv_w[(l * 3 + 1) * 3072 + 2048 + c], cwv2 = P.conv_w[(l * 3 + 2) * 3072 + 2048 + c];
  const float cw00 = P.conv_w[(l * 3 + 0) * 3072 + c], cw01 = P.conv_w[(l * 3 + 1) * 3072 + c], cw02 = P.conv_w[(l * 3 + 2) * 3072 + c];
  const float cb0 = P.conv_b[l * 3072 + c], cb1 = P.conv_b[l * 3072 + 1024 + c], cbv = P.conv_b[l * 3072 + 2048 + c];
  const float Dc = P.hy_D[l * 1024 + c];
  for (int pr = 0; pr < 2; ++pr) {
    const int b0 = 2 * pr, b1 = 2 * pr + 1;
    bf16* rows = (bf16*)(smem + 34816);
    {
      const int tl = launder(t);
#pragma unroll
      for (int q = 0; q < 8; ++q) {
        const int rr = q >> 1, ch = tl + 256 * (q & 1);
        const int bb = (rr >> 1) ? b1 : b0, grp = (rr & 1) ? 2048 : 1024;
        uint4 v = *(const uint4*)(P.pT + ((size_t)bb * NHYC + grp + c) * 4096 + ch * 8);
        *(uint4*)(rows + rr * 4096 + ch * 8) = v;
      }
    }
    __syncthreads();
    cf u[16], x[16];
#pragma unroll 2
    for (int j = 0; j < 16; ++j) {
      int n = 256 * j + t;
      float ua = convl(rows, n, cw10, cw11, cw12, cb1) * convl(rows + 4096, n, cwv0, cwv1, cwv2, cbv);
      float ub = convl(rows + 8192, n, cw10, cw11, cw12, cb1) * convl(rows + 12288, n, cwv0, cwv1, cwv2, cbv);
      lds[(t + (t >> 4)) + 272 * j] = cf{ua, ub};
    }
#pragma unroll
    for (int j = 0; j < 16; ++j) { u[j] = lds[(t + (t >> 4)) + 272 * j]; x[j] = u[j]; }
    __syncthreads();
    fft_fwd(x, t, tw, lds);
    { const int tl = launder(t); _Pragma("unroll") for (int r = 0; r < 16; ++r) x[r] = cmul(x[r], kfe[r * 256 + tl]); }
    fft_inv(x, t, tw, lds);
#pragma unroll
    for (int j = 0; j < 16; ++j) est[256 * j + t] = x[j];
    {
      cf wn = cf{launderf(c8.x), launderf(c8.y)};
#pragma unroll
      for (int j = 0; j < 16; ++j) { x[j] = cmul(u[j], wn); wn = cmul(wn, w32); }
    }
    fft_fwd(x, t, tw, lds);
    { const int tl = launder(t); _Pragma("unroll") for (int r = 0; r < 16; ++r) x[r] = cmul(x[r], kfo[r * 256 + tl]); }
    fft_inv(x, t, tw, lds);
    {
      cf wn = cf{launderf(c8.x), launderf(c8.y)};
#pragma unroll
      for (int j = 0; j < 16; ++j) {
        cf o = cmulc(x[j], wn);
        cf e = est[256 * j + t];
        est[256 * j + t] = cf{(e.x + o.x) * (1.f / 8192.f) + Dc * u[j].x, (e.y + o.y) * (1.f / 8192.f) + Dc * u[j].y};
        wn = cmul(wn, w32);
      }
    }
    bf16* r0 = (bf16*)smem;
    {
      const int tl = launder(t);
#pragma unroll
      for (int q = 0; q < 4; ++q) {
        const int rr = q >> 1, ch = tl + 256 * (q & 1);
        const int bb = rr ? b1 : b0;
        uint4 v = *(const uint4*)(P.pT + ((size_t)bb * NHYC + c) * 4096 + ch * 8);
        *(uint4*)(r0 + rr * 4096 + ch * 8) = v;
      }
    }
    __syncthreads();
    bf16* oa = P.yhT + ((size_t)b0 * 1024 + c) * 4096;
    bf16* ob = P.yhT + ((size_t)b1 * 1024 + c) * 4096;
#pragma unroll 2
    for (int j = 0; j < 16; ++j) {
      int n = 256 * j + t;
      cf yv = est[n];
      float xa = convl(r0, n, cw00, cw01, cw02, cb0), xb = convl(r0 + 4096, n, cw00, cw01, cw02, cb0);
      oa[n] = f2bf(xa * yv.x);
      ob[n] = f2bf(xb * yv.y);
    }
    __syncthreads();
  }
}
__device__ void hyena_ctx_task(const Params& P, int c, char* smem) {
  float* hf = (float*)smem;
  float* hb = hf + 256;
  float* us = hb + 256;
  const int t = launder((int)threadIdx.x & 255);
  const int l = 0;
  float af = 0.f, ab = 0.f;
  float* w3c = us + 4 * 256;
  if (t < 128) w3c[t] = P.filt_w3[((size_t)l * 64 + (t & 63)) * 2048 + (t >> 6) * 1024 + c];
  __syncthreads();
#pragma unroll 16
  for (int i = 0; i < 64; ++i) {
    float hv = P.h2cT[i * 256 + t];
    af += hv * w3c[i];
    ab += hv * w3c[64 + i];
  }
  const float d0 = -15.350567286626973f, d1 = -3.0701134573253946f;
  const float adel = fabsf(d0 + (float)c * ((d1 - d0) / 1023.f));
  float dec = expf(-((float)t / 255.f) * adel);
  hf[t] = af * dec; hb[t] = ab * dec;
  float x0c[4], uu[4];
#pragma unroll
  for (int b = 0; b < 4; ++b) {
    const bf16* base = P.pchy + (size_t)(b * NHYC) * 256;
    float cv[3];
#pragma unroll
    for (int g = 0; g < 3; ++g) {
      int col = g * 1024 + c;
      const bf16* rowp = base + (size_t)col * 256;
      float a = P.conv_b[l * 3072 + col] + P.conv_w[(l * 3 + 1) * 3072 + col] * bf2f(rowp[t]);
      if (t > 0) a += P.conv_w[(l * 3 + 0) * 3072 + col] * bf2f(rowp[t - 1]);
      if (t < 255) a += P.conv_w[(l * 3 + 2) * 3072 + col] * bf2f(rowp[t + 1]);
      cv[g] = a;
    }
    x0c[b] = cv[0]; uu[b] = cv[1] * cv[2];
    us[b * 256 + t] = uu[b];
  }
  __syncthreads();
  float acc[4] = {0.f, 0.f, 0.f, 0.f};
  for (int s = 0; s < 256; ++s) {
    float k = (s <= t) ? hf[t - s] : hb[s - t];
#pragma unroll
    for (int b = 0; b < 4; ++b) acc[b] += k * us[b * 256 + s];
  }
  const float Dc = P.hy_D[l * 1024 + c];
#pragma unroll
  for (int b = 0; b < 4; ++b) {
    int row = TX + b * 256 + t;
    P.xh[(size_t)row * 2048 + 1024 + c] = f2bf(x0c[b] * (acc[b] + Dc * uu[b]));
  }
  __syncthreads();
}
__device__ void phase_d(const Params& P, int l, char* smem, char* smem_all) {
  const int nhx = 1024, nhc = (l == 0) ? 1024 : 0;
  for (int pr = blockIdx.x; pr < ((nhx + nhc) >> 1); pr += gridDim.x) {
    const int id = 2 * pr + VHALF;
    if (id < nhx) hyena_x_task(P, l, id, smem);
    else hyena_ctx_task(P, id - nhx, smem);
  }
  __syncthreads();
  const int nqm = (l == 0) ? 68 : 64;
  const int nq = nqm * 6, nkv = 68 * 8;
  for (int L = blockIdx.x; L < nq + nkv; L += gridDim.x) {
    if (L < nkv) kv_gemm_task(P, l, L >> 3, L & 7, smem_all);
    else { int i = L - nkv; q_gemm_task(P, l, i / 6, i % 6, smem_all); }
  }
}

__device__ void attn_task(const Params& P, int b, int h, int qrow0, int nkt, char* smem) {
  const int tid = launder((int)threadIdx.x), lane = tid & 63, w = tid >> 6, l15 = lane & 15, quad = lane >> 4;
  bf16x8 qf[2][6];
#pragma unroll
  for (int m = 0; m < 2; ++m)
#pragma unroll
    for (int ks = 0; ks < 6; ++ks)
      qf[m][ks] = *(const bf16x8*)(P.qbuf + (size_t)(qrow0 + w * 32 + m * 16 + l15) * QW + h * 192 + ks * 32 + quad * 8);
  const bf16* Kg = P.Kn + ((size_t)b * 8 + h) * LK * 128;
  const bf16* Rg = P.kr + (size_t)b * LK * 64;
  const bf16* Vg = P.vT + ((size_t)b * 8 + h) * 128 * LK;
  uint4 sk0, sk1, sr0, sv0, sv1;
  const int vok = (tid >> 4) * 128 + (tid & 15) * 8;
  const int vor = (tid >> 3) * 64 + (tid & 7) * 8;
  const int vov = (tid >> 3) * LK + (tid & 7) * 8;
  const int lok = (tid >> 4) * 400 + (tid & 15) * 16;
  const int lor = (tid >> 3) * 400 + 256 + (tid & 7) * 16;
  const int lov = 25600 + (tid >> 3) * 144 + (tid & 7) * 16;
#define GLOADKV(kt) do { const bf16* kb = Kg + (size_t)(kt) * 64 * 128; const bf16* rb = Rg + (size_t)(kt) * 64 * 64; const bf16* vb = Vg + (kt) * 64; \
    sk0 = *(const uint4*)(kb + vok); sk1 = *(const uint4*)(kb + (vok + 32 * 128)); sr0 = *(const uint4*)(rb + vor); \
    sv0 = *(const uint4*)(vb + vov); sv1 = *(const uint4*)(vb + (vov + 64 * LK)); } while (0)
#define LSTOREKV(bufp) do { *(uint4*)((bufp) + lok) = sk0; *(uint4*)((bufp) + lok + 32 * 400) = sk1; *(uint4*)((bufp) + lor) = sr0; \
    *(uint4*)((bufp) + lov) = sv0; *(uint4*)((bufp) + lov + 64 * 144) = sv1; } while (0)
  f32x4 oacc[8][2];
#pragma unroll
  for (int nd = 0; nd < 8; ++nd) { oacc[nd][0] = f32x4{0.f, 0.f, 0.f, 0.f}; oacc[nd][1] = f32x4{0.f, 0.f, 0.f, 0.f}; }
  float mrow[2] = {-1e30f, -1e30f}, lrow[2] = {0.f, 0.f};
  GLOADKV(0);
  LSTOREKV(smem);
  __syncthreads();
  for (int kt = 0; kt < nkt; ++kt) {
    const bool more = kt + 1 < nkt;
    const char* Ks = smem + (kt & 1) * 44032;
    const char* Vs = Ks + 25600;
    char* nbuf = smem + ((kt + 1) & 1) * 44032;
    if (more) GLOADKV(kt + 1);
    f32x4 s[4][2];
#pragma unroll
    for (int n = 0; n < 4; ++n) { s[n][0] = f32x4{0.f, 0.f, 0.f, 0.f}; s[n][1] = f32x4{0.f, 0.f, 0.f, 0.f}; }
    __builtin_amdgcn_s_setprio(1);
#pragma unroll
    for (int ks = 0; ks < 6; ++ks) {
#pragma unroll
      for (int n = 0; n < 4; ++n) {
        bf16x8 a = *(const bf16x8*)(Ks + (n * 16 + l15) * 400 + ks * 64 + quad * 16);
        s[n][0] = __builtin_amdgcn_mfma_f32_16x16x32_bf16(a, qf[0][ks], s[n][0], 0, 0, 0);
        s[n][1] = __builtin_amdgcn_mfma_f32_16x16x32_bf16(a, qf[1][ks], s[n][1], 0, 0, 0);
      }
      if (ks & 1) __builtin_amdgcn_sched_barrier(0);
    }
    __builtin_amdgcn_s_setprio(0);
    bf16x8 pb[2][2];
#pragma unroll
    for (int m = 0; m < 2; ++m) {
      float mx = vmax3(s[0][m][0], s[0][m][1], s[0][m][2]);
      mx = vmax3(mx, s[0][m][3], s[1][m][0]); mx = vmax3(mx, s[1][m][1], s[1][m][2]); mx = vmax3(mx, s[1][m][3], s[2][m][0]);
      mx = vmax3(mx, s[2][m][1], s[2][m][2]); mx = vmax3(mx, s[2][m][3], s[3][m][0]); mx = vmax3(mx, s[3][m][1], s[3][m][2]);
      mx = vmax(mx, s[3][m][3]);
      mx = vmax(mx, __shfl_xor(mx, 16));
      mx = vmax(mx, __shfl_xor(mx, 32));
      float mn = vmax(mrow[m], mx);
      float alpha = __builtin_amdgcn_exp2f(mrow[m] - mn);
      mrow[m] = mn;
      float ps = 0.f;
#pragma unroll
      for (int n = 0; n < 4; ++n)
#pragma unroll
        for (int j = 0; j < 4; ++j) { float p = __builtin_amdgcn_exp2f(s[n][m][j] - mn); s[n][m][j] = p; ps += p; }
      lrow[m] = lrow[m] * alpha + ps;
      if (!__all(alpha == 1.f)) {
#pragma unroll
        for (int nd = 0; nd < 8; ++nd) { oacc[nd][m][0] *= alpha; oacc[nd][m][1] *= alpha; oacc[nd][m][2] *= alpha; oacc[nd][m][3] *= alpha; }
      }
#pragma unroll
      for (int k2 = 0; k2 < 2; ++k2) {
        uint4 pk;
        pk.x = pack2(s[2 * k2][m][0], s[2 * k2][m][1]); pk.y = pack2(s[2 * k2][m][2], s[2 * k2][m][3]);
        pk.z = pack2(s[2 * k2 + 1][m][0], s[2 * k2 + 1][m][1]); pk.w = pack2(s[2 * k2 + 1][m][2], s[2 * k2 + 1][m][3]);
        pb[m][k2] = *(bf16x8*)&pk;
      }
    }
    __builtin_amdgcn_sched_barrier(0);
    __builtin_amdgcn_s_setprio(1);
#pragma unroll
    for (int nd = 0; nd < 8; ++nd) {
      if ((nd & 1) == 0) __builtin_amdgcn_sched_barrier(0);
#pragma unroll
      for (int k2 = 0; k2 < 2; ++k2) {
        const char* vp = Vs + (nd * 16 + l15) * 144 + k2 * 64 + quad * 8;
        uint2 lo = *(const uint2*)(vp), hi = *(const uint2*)(vp + 32);
        uint4 av = uint4{lo.x, lo.y, hi.x, hi.y};
        bf16x8 a = *(bf16x8*)&av;
        oacc[nd][0] = __builtin_amdgcn_mfma_f32_16x16x32_bf16(a, pb[0][k2], oacc[nd][0], 0, 0, 0);
        oacc[nd][1] = __builtin_amdgcn_mfma_f32_16x16x32_bf16(a, pb[1][k2], oacc[nd][1], 0, 0, 0);
      }
    }
    __builtin_amdgcn_s_setprio(0);
    if (more) LSTOREKV(nbuf);
    __syncthreads();
  }
#undef GLOADKV
#undef LSTOREKV
#pragma unroll
  for (int m = 0; m < 2; ++m) {
    float lt = lrow[m];
    lt += __shfl_xor(lt, 16);
    lt += __shfl_xor(lt, 32);
    float inv = 1.f / lt;
    int row = qrow0 + w * 32 + m * 16 + l15;
#pragma unroll
    for (int nd = 0; nd < 8; ++nd) {
      uint2 o; o.x = pack2(oacc[nd][m][0] * inv, oacc[nd][m][1] * inv); o.y = pack2(oacc[nd][m][2] * inv, oacc[nd][m][3] * inv);
      *(uint2*)(P.xh + (size_t)row * 2048 + h * 128 + nd * 16 + quad * 4) = o;
    }
  }
}
__device__ void phase_attn(const Params& P, int l, char* smem) {
  const int nx = 512, nc = (l == 0) ? 32 : 0;
  for (int id = blockIdx.x; id < nx + nc; id += gridDim.x) {
    if (id < nx) {
      int j = id >> 3;
      int bh = (id & 7) + 8 * (j >> 4), qt = j & 15;
      int b = bh >> 3, h = bh & 7;
      attn_task(P, b, h, b * 4096 + qt * 256, 68, smem);
    } else {
      int bh = id - nx;
      int b = bh >> 3, h = bh & 7;
      attn_task(P, b, h, TX + b * 256, 4, smem);
    }
  }
}

__device__ __forceinline__ void unpack8(uint4 v, float* f) {
  f[0] = __uint_as_float(v.x << 16); f[1] = __uint_as_float(v.x & 0xffff0000u);
  f[2] = __uint_as_float(v.y << 16); f[3] = __uint_as_float(v.y & 0xffff0000u);
  f[4] = __uint_as_float(v.z << 16); f[5] = __uint_as_float(v.z & 0xffff0000u);
  f[6] = __uint_as_float(v.w << 16); f[7] = __uint_as_float(v.w & 0xffff0000u);
}
__device__ __forceinline__ void merge_row(const Params& P, int row, const char* yh_lds  , int lane) {
  bf16* yr = P.xh + (size_t)row * 2048;
  const bf16* gr = P.pa + (size_t)row * NPA;
  float o[2][8], y[2][8];
  float so = 0.f, sy = 0.f;
#pragma unroll
  for (int i = 0; i < 2; ++i) {
    int col = i * 512 + lane * 8;
    unpack8(*(const uint4*)(yr + col), o[i]);
    uint4 yv = yh_lds ? *(const uint4*)(yh_lds + col * 2) : *(const uint4*)(yr + 1024 + col);
    unpack8(yv, y[i]);
#pragma unroll
    for (int e = 0; e < 8; ++e) { so += o[i][e] * o[i][e]; sy += y[i][e] * y[i][e]; }
  }
  so = wave_sum(so); sy = wave_sum(sy);
  float rm = rsqrtf(so * (1.f / 1024.f) + EPSN), rh = rsqrtf(sy * (1.f / 1024.f) + EPSN);
#pragma unroll
  for (int i = 0; i < 2; ++i) {
    int col = i * 512 + lane * 8;
    float gm[8], gh[8];
    unpack8(*(const uint4*)(gr + 832 + col), gm);
    unpack8(*(const uint4*)(gr + 1856 + col), gh);
    uint4 a, b;
    a.x = pack2(o[i][0] * rm * siluf(gm[0]), o[i][1] * rm * siluf(gm[1]));
    a.y = pack2(o[i][2] * rm * siluf(gm[2]), o[i][3] * rm * siluf(gm[3]));
    a.z = pack2(o[i][4] * rm * siluf(gm[4]), o[i][5] * rm * siluf(gm[5]));
    a.w = pack2(o[i][6] * rm * siluf(gm[6]), o[i][7] * rm * siluf(gm[7]));
    b.x = pack2(y[i][0] * rh * siluf(gh[0]), y[i][1] * rh * siluf(gh[1]));
    b.y = pack2(y[i][2] * rh * siluf(gh[2]), y[i][3] * rh * siluf(gh[3]));
    b.z = pack2(y[i][4] * rh * siluf(gh[4]), y[i][5] * rh * siluf(gh[5]));
    b.w = pack2(y[i][6] * rh * siluf(gh[6]), y[i][7] * rh * siluf(gh[7]));
    *(uint4*)(yr + col) = a;
    *(uint4*)(yr + 1024 + col) = b;
  }
}
__device__ void merge_x_task(const Params& P, int task, char* smem) {
  const int tid = launder((int)threadIdx.x & 255), lane = tid & 63, w = tid >> 6;
  const int b = task >> 7, tt = task & 127;
  constexpr int RS = 2064;
#pragma unroll 4
  for (int i = 0; i < 16; ++i) {
    int id = tid + 256 * i, cch = id >> 2, q = id & 3;
    uint4 v = *(const uint4*)(P.yhT + ((size_t)b * 1024 + cch) * 4096 + tt * 32 + q * 8);
    unsigned uu[4] = {v.x, v.y, v.z, v.w};
#pragma unroll
    for (int e = 0; e < 4; ++e) {
      *(bf16*)(smem + (q * 8 + 2 * e) * RS + cch * 2) = (bf16)(uu[e] & 0xffffu);
      *(bf16*)(smem + (q * 8 + 2 * e + 1) * RS + cch * 2) = (bf16)(uu[e] >> 16);
    }
  }
  HSYNC();
  for (int rr = 0; rr < 8; ++rr) {
    int tk = w * 8 + rr;
    merge_row(P, b * 4096 + tt * 32 + tk, smem + tk * RS, lane);
  }
  HSYNC();
}
__device__ void phase_merge(const Params& P, int l, char* smem) {
  const int nx = 512, nc = (l == 0) ? 256 : 0, nw = (l == 0) ? 3072 : 0;
  for (int id = VBID; id < nx + nc + nw; id += VGRID) {
    if (id < nx) merge_x_task(P, id, smem);
    else if (id < nx + nc) { int row = TX + (id - nx) * 4 + (launder((int)threadIdx.x & 255) >> 6); merge_row(P, row, nullptr, launder((int)threadIdx.x & 255) & 63); }
    else win_transpose_task(P, 1, id - nx - nc, smem);
  }
}

__device__ void phase_gemm_out(const Params& P, int l, char* smem) {
  const int nM = (l == 0) ? 68 : 64, nN = 8;
  for (int L = blockIdx.x; L < nM * nN; L += gridDim.x) {
    int mt, nt;
    g2_tile(L, nM, nN, mt, nt);
    f32x4 acc[2][2][4][2];
    const int row0 = mt * 256, col0 = nt * 256;
    gemm256_8p(P.xh + (size_t)row0 * DM, P.wT_out + (size_t)l * DM * DM + (size_t)col0 * DM, smem, acc);
    const int tid = launder((int)threadIdx.x), lane = tid & 63, w = tid >> 6, wr = w >> 2, wc = w & 3, l15 = lane & 15, quad = lane >> 4;
#pragma unroll
    for (int ai = 0; ai < 2; ++ai)
#pragma unroll
      for (int bj = 0; bj < 2; ++bj)
#pragma unroll
        for (int m = 0; m < 4; ++m)
#pragma unroll
          for (int n = 0; n < 2; ++n)
#pragma unroll
            for (int j = 0; j < 4; ++j) {
              int row = row0 + ai * 128 + wr * 64 + m * 16 + quad * 4 + j, col = col0 + bj * 128 + wc * 32 + n * 16 + l15;
              P.z[(size_t)row * 2048 + col] = acc[ai][bj][m][n][j];
            }
    __syncthreads();
  }
}

__device__ void phase_a(const Params& P, char* smem) {
  const int n0 = 192, n1 = n0 + 2112, n2 = n1, n3 = n2 + 3072, n4 = n3 + 384, n5 = n4 + 256, n6 = n5 + 2048;
  for (int id = VBID; id < n6 + 1; id += VGRID) {
    if (id < n0) modulation_task(P, id, smem);
    else if (id < n1) h2_task(P, id - n0, smem);
    else if (id == n6) rope_table_task(P);
    else if (id < n3) win_transpose_task(P, 0, id - n2, smem);
    else if (id < n4) {
      int i = id - n3, l = i / 192, r = i % 192, nt = r >> 3, kt = r & 7;
      transpose_tile(P.w_uq + (size_t)l * 512 * QW, QW, kt * 64, nt * 64, P.wT_uq + (size_t)l * QW * 512, 512, nt * 64, P.q_norm_g + l * 512, false, smem);
    } else if (id < n5) {
      int i = id - n4, l = i / 128, r = i % 128, nt = r >> 2, kt = r & 3;
      transpose_tile(P.w_ukv + (size_t)l * 256 * 2048, 2048, kt * 64, nt * 64, P.wT_ukv + (size_t)l * 2048 * 256, 256, nt * 64, P.kv_norm_g + l * 256, false, smem);
    } else {
      int i = id - n5, l = i / 1024, r = i % 1024, nt = r >> 5, kt = r & 31;
      const float* gk = (kt < 16) ? (P.grp_g_mla + l * 1024) : (P.grp_g_hy + l * 1024 - 1024);
      transpose_tile(P.w_out + (size_t)l * DM * DM, DM, kt * 64, nt * 64, P.wT_out + (size_t)l * DM * DM, DM, nt * 64, gk, false, smem);
    }
  }
}


#define XB_TMO      128
#define XB_XCNT(j)  (256  + 64 * (j))
#define XB_XSUB(j)  (1280 + 64 * (j))
#define XB_XGEN(j)  (2304 + 64 * (j))
#define XB_TOP      3328
#define XB_TOPGEN   3392
#define XCD_BAR_WORDS 3456
#define XB_SPIN_CAP (1u << 20)
#define LAS __attribute__((address_space(3)))
__device__ __forceinline__ unsigned xb_ld(unsigned* p) { return __hip_atomic_load(p, __ATOMIC_RELAXED, __HIP_MEMORY_SCOPE_AGENT); }
__device__ __forceinline__ unsigned xb_add(unsigned* p, unsigned v) { return __hip_atomic_fetch_add(p, v, __ATOMIC_RELAXED, __HIP_MEMORY_SCOPE_AGENT); }
__device__ __forceinline__ unsigned xb_xcc_id() { return (unsigned)__builtin_amdgcn_s_getreg((3 << 11) | 20) & 0xFu; }
#define XB_SPIN(cond, bar) do { unsigned _sp = 0; while (cond) { __builtin_amdgcn_s_sleep(1); \
    if ((++_sp & 255u) == 0u) { if (xb_ld(&(bar)[XB_TMO])) break; if (_sp > XB_SPIN_CAP) { atomicAdd(&(bar)[XB_TMO], 1u); break; } } } } while (0)
struct XcdBarrier { unsigned* bar; unsigned x; volatile LAS unsigned* st; };
__device__ __forceinline__ XcdBarrier xcd_barrier_post(unsigned* bar, volatile LAS unsigned* st) {
  XcdBarrier b; b.bar = bar; b.x = xb_xcc_id(); b.st = st;
  if (threadIdx.x == 0) (void)xb_add(&bar[XB_XCNT(b.x)], 1u);
  return b;
}
__device__ __forceinline__ void xcd_barrier_complete(unsigned* bar, unsigned x, unsigned& nloc, unsigned& nx) {
  const unsigned G = gridDim.x * gridDim.y * gridDim.z;
  unsigned sum, cnt, mine, sp = 0u;
  for (;;) {
    sum = 0u; cnt = 0u; mine = 0u;
#pragma unroll
    for (unsigned j = 0; j < 16; ++j) { const unsigned c = xb_ld(&bar[XB_XCNT(j)]); sum += c; cnt += (c > 0u) ? 1u : 0u; mine = (j == x) ? c : mine; }
    if (sum == G) break;
    __builtin_amdgcn_s_sleep(1);
    if ((++sp & 255u) == 0u) { if (xb_ld(&bar[XB_TMO])) break; if (sp > XB_SPIN_CAP) { atomicAdd(&bar[XB_TMO], 1u); break; } }
  }
  nloc = mine > 0u ? mine : 1u; nx = cnt > 0u ? cnt : 1u;
}
__device__ __forceinline__ void xcd_barrier(const XcdBarrier& b) {
  asm volatile("s_waitcnt vmcnt(0)" ::: "memory");
  __syncthreads();
  if (threadIdx.x == 0) {
    unsigned* bar = b.bar;
    __builtin_amdgcn_s_waitcnt(0);
    unsigned nloc = b.st[0], nx = b.st[1];
    if (nloc == 0u) { xcd_barrier_complete(bar, b.x, nloc, nx); b.st[0] = nloc; b.st[1] = nx; }
    const unsigned old = xb_add(&bar[XB_XSUB(b.x)], 1u);
    const unsigned gen = old / nloc;
    if (old + 1u == (gen + 1u) * nloc) {
      __builtin_amdgcn_fence(__ATOMIC_RELEASE, "agent");
      asm volatile("s_waitcnt vmcnt(0)" ::: "memory");
      const unsigned og = xb_add(&bar[XB_TOP], 1u);
      const unsigned tg = og / nx;
      if (og + 1u == (tg + 1u) * nx) xb_add(&bar[XB_TOPGEN], 1u);
      else XB_SPIN(xb_ld(&bar[XB_TOPGEN]) == tg, bar);
      __builtin_amdgcn_fence(__ATOMIC_ACQUIRE, "agent");
      xb_add(&bar[XB_XGEN(b.x)], 1u);
      asm volatile("s_waitcnt vmcnt(0)" ::: "memory");
    } else {
      XB_SPIN(xb_ld(&bar[XB_XGEN(b.x)]) == gen, bar);
      __builtin_amdgcn_fence(__ATOMIC_ACQUIRE, "agent");
      asm volatile("s_waitcnt vmcnt(0)" ::: "memory");
    }
  }
  __syncthreads();
}

#ifndef MINB
#define MINB 2
#endif
__global__ void __launch_bounds__(512, MINB) hymba_fwd(Params Pin) {
  extern __shared__ __attribute__((aligned(1024))) char smem_all[];
  char* smem = smem_all + VHALF * HALF_LDS;
  cg::grid_group grid = cg::this_grid();
#ifndef PM
#define PM 0xffff
#endif
  typedef const Params __attribute__((address_space(4))) * KP4;
#if defined(__HIP_DEVICE_COMPILE__)
#define GETP() ([&]() { KP4 kp = (KP4)__builtin_amdgcn_kernarg_segment_ptr(); asm volatile("" : "+s"(kp)); Params q = *kp; return q; }())
#else
#define GETP() Pin
#endif
  volatile LAS unsigned* xst = (volatile LAS unsigned*)(smem_all + LDS_BYTES - 16);
  if (threadIdx.x < 4) xst[threadIdx.x] = 0u;
  if (threadIdx.x >= 8 && threadIdx.x < 16) ((volatile LAS unsigned*)(smem_all + LDS_BYTES - 64))[threadIdx.x - 8] = 0u;
  __syncthreads();
  (void)xcd_barrier_post(Pin.bar, xst);
#define XBAR() do { XcdBarrier xb_; xb_.bar = GETP().bar; xb_.x = xb_xcc_id(); xb_.st = (volatile LAS unsigned*)(smem_all + LDS_BYTES - 16); xcd_barrier(xb_); } while (0)
  if (PM & 1) phase_a(GETP(), smem);
  if (Pin.reps[6] != 0) grid.sync();
  XBAR();
  if (PM & 2) phase_prenorm0(GETP());
  XBAR();
#pragma unroll 1
  for (int l = 0; l < 2; ++l) {
#ifndef REP
#define REP 0
#endif
    const int r0 = Pin.reps[0], r1 = Pin.reps[1], r2 = Pin.reps[2], r3 = Pin.reps[3];
#pragma unroll 1
    for (int r = 0; r < r0; ++r) { phase_gemm_in(GETP(), l, smem_all); XBAR(); }
#pragma unroll 1
    for (int r = 0; r < r1; ++r) { phase_d(GETP(), l, smem, smem_all); XBAR(); }
#pragma unroll 1
    for (int r = 0; r < r2; ++r) { phase_attn(GETP(), l, smem_all); XBAR(); }
    if (PM & 32) phase_merge(GETP(), l, smem);
    XBAR();
#pragma unroll 1
    for (int r = 0; r < r3; ++r) { phase_gemm_out(GETP(), l, smem_all); XBAR(); }
    if (PM & 128) phase_post(GETP(), l);
    if (l == 0) XBAR();
  }
}

extern "C" void kernel_launch(void* const* d_in, const int* in_sizes, int n_in, void* d_out, int out_size, void* d_ws, size_t ws_size,
                              hipStream_t stream) {
  static int grid_blocks = 0;
  if (grid_blocks == 0) {
    int dev = 0, cus = 0, per_cu = 0;
    hipGetDevice(&dev);
    hipDeviceGetAttribute(&cus, hipDeviceAttributeMultiprocessorCount, dev);
    if (hipFuncSetAttribute((const void*)hymba_fwd, hipFuncAttributeMaxDynamicSharedMemorySize, LDS_BYTES) != hipSuccess) {
      fprintf(stderr, "hipFuncSetAttribute failed\n"); grid_blocks = -1; return;
    }
    hipOccupancyMaxActiveBlocksPerMultiprocessor(&per_cu, (const void*)hymba_fwd, NT, LDS_BYTES);
    if (per_cu < 1) per_cu = 1;
    if (per_cu > 1) per_cu = 1;
    grid_blocks = cus * per_cu;
  }
  if (grid_blocks < 0) return;
  Params p{};
  const float** pin = (const float**)&p;
  for (int i = 0; i < 25; ++i) pin[i] = (const float*)d_in[i];
  p.out = (float*)d_out;
  char* ws = (char*)d_ws;
  size_t off = 0;
  auto take = [&](size_t bytes) { char* r = ws + off; off += (bytes + 255) & ~(size_t)255; return r; };
  p.wT_in = (bf16*)take((size_t)NPADW * DM * 2);
  p.wT_uq = (bf16*)take((size_t)2 * QW * 512 * 2);
  p.wT_ukv = (bf16*)take((size_t)2 * 2048 * 256 * 2);
  p.wT_out = (bf16*)take((size_t)2 * DM * DM * 2);
  p.mod = (float*)take((size_t)2 * 5 * 6144 * 4);
  p.h2T = (bf16*)take((size_t)2 * 64 * 4096 * 2);
  p.h2cT = (float*)take((size_t)64 * 256 * 4);
  p.rope = (float*)take((size_t)64 * 16 * 2 * 4);
  p.xh = (bf16*)take((size_t)TT * DM * 2);
  p.pa = (bf16*)take((size_t)TT * NPA * 2);
  p.pT = (bf16*)take((size_t)4 * NHYC * 4096 * 2);
  p.pchy = (bf16*)take((size_t)TC * NHYC * 2);
  p.z = (float*)p.pa;
  p.qbuf = (bf16*)take((size_t)TT * QW * 2);
  p.Kn = (bf16*)take((size_t)4 * 8 * LK * 128 * 2);
  p.kr = (bf16*)take((size_t)4 * LK * 64 * 2);
  p.vT = (bf16*)take((size_t)4 * 8 * 128 * LK * 2);
  p.yhT = (bf16*)take((size_t)4 * 1024 * 4096 * 2);
  p.ctx1 = (float*)take((size_t)TC * DM * 4);
  p.kfg = (float*)take((size_t)grid_blocks * 2 * 2 * 4096 * 8);
  p.bar = (unsigned*)take((size_t)XCD_BAR_WORDS * 4);
  if (off > ws_size) { fprintf(stderr, "workspace too small: need %zu have %zu\n", off, ws_size); return; }
#ifndef REPS
#define REPS 1, 1, 1, 1
#endif
  { const int rr[4] = {REPS}; for (int i = 0; i < 4; ++i) p.reps[i] = rr[i]; }
  if (hipMemsetAsync(p.bar, 0, (size_t)XCD_BAR_WORDS * 4, stream) != hipSuccess) { fprintf(stderr, "memset failed\n"); return; }
  void* args[] = {&p};
  hipError_t e = hipLaunchCooperativeKernel((void*)hymba_fwd, dim3(grid_blocks), dim3(NT), args, LDS_BYTES, stream);
  if (e != hipSuccess) fprintf(stderr, "cooperative launch failed: %s (grid %d)\n", hipGetErrorString(e), grid_blocks);
}
```
